# Optimizing an MI355X kernel written in HIP

```python
import math
import jax, jax.numpy as jnp
from jax import lax
import numpy as np

D_MODEL = 1024
BATCH = 4
SEQ = 4096
DEPTH = 2

HEAD_DIM = 64
N_HEADS_DIFF = 8
N_HEADS_MOBA = 8
DIFF_HALF = HEAD_DIM // 2
MOBA_BLOCK = 256
MOBA_TOPK = 3
MOBA_Q_CHUNK = 64
ATTN_Q_BLOCK = 128
GMLP_CHUNK = 128
GMLP_GROUPS = 8
GMLP_WIDTH = 512
CONV_CH = 512
CONV_KERNEL = 31
D_FF = -(-8 * D_MODEL // (3 * 256)) * 256
ROPE_THETA = 10000.0
EPS = 1e-6
N_EVEN = (DEPTH + 1) // 2
N_ODD = DEPTH // 2
EVEN_IN = 3 * N_HEADS_DIFF * HEAD_DIM + 3 * N_HEADS_MOBA * HEAD_DIM
EVEN_OUT = (N_HEADS_DIFF + N_HEADS_MOBA) * HEAD_DIM
ODD_IN = 2 * GMLP_WIDTH + 2 * CONV_CH
ODD_OUT = GMLP_WIDTH + CONV_CH

kernel_name = "hybrid_diffattn_moba_gmlp_conformer_block"


def rms_norm(x, g):
    xf = x.astype(jnp.float32)
    y = xf * lax.rsqrt(jnp.mean(xf * xf, axis=-1, keepdims=True) + EPS)
    return (y * g.astype(jnp.float32)).astype(x.dtype)


def layer_norm(x, g, b):
    xf = x.astype(jnp.float32)
    mu = jnp.mean(xf, axis=-1, keepdims=True)
    xc = xf - mu
    y = xc * lax.rsqrt(jnp.mean(xc * xc, axis=-1, keepdims=True) + EPS)
    return (y * g.astype(jnp.float32) + b.astype(jnp.float32)).astype(x.dtype)


def rope_tables(dim):
    inv = 1.0 / (ROPE_THETA ** (jnp.arange(0, dim, 2, dtype=jnp.float32) / dim))
    ang = jnp.arange(SEQ, dtype=jnp.float32)[:, None] * inv[None, :]
    return jnp.cos(ang), jnp.sin(ang)


def apply_rope(x, cos, sin):
    x1, x2 = jnp.split(x, 2, axis=-1)
    c = cos.astype(x.dtype)
    s = sin.astype(x.dtype)
    return jnp.concatenate([x1 * c - x2 * s, x2 * c + x1 * s], axis=-1)


def diff_attention(q, k, v, lam):
    B, H = q.shape[0], q.shape[1]
    nq = SEQ // ATTN_Q_BLOCK
    scale = DIFF_HALF ** -0.5
    qb = jnp.moveaxis(q.reshape(B, H, 2, nq, ATTN_Q_BLOCK, DIFF_HALF), 3, 0)
    kpos = jnp.arange(SEQ)

    def block(args):
        q_blk, i = args
        s = jnp.einsum('bhmqd,bhmkd->bhmqk', q_blk, k).astype(jnp.float32) * scale
        qpos = i * ATTN_Q_BLOCK + jnp.arange(ATTN_Q_BLOCK)
        s = jnp.where(kpos[None, :] <= qpos[:, None], s, -jnp.inf)
        p = jax.nn.softmax(s, axis=-1)
        w = p[:, :, 0] - lam * p[:, :, 1]
        return jnp.einsum('bhqk,bhkd->bhqd', w.astype(v.dtype), v)

    out = lax.map(block, (qb, jnp.arange(nq)))
    return jnp.moveaxis(out, 0, 2).reshape(B, H, SEQ, HEAD_DIM)


def moba_attention(q, k, v):
    B, H, S, D = q.shape
    nb = -(-S // MOBA_BLOCK)
    pad = nb * MOBA_BLOCK - S
    kp = jnp.pad(k, ((0, 0), (0, 0), (0, pad), (0, 0)))
    vp = jnp.pad(v, ((0, 0), (0, 0), (0, pad), (0, 0)))
    kb = kp.reshape(B, H, nb, MOBA_BLOCK, D)
    vb = vp.reshape(B, H, nb, MOBA_BLOCK, D)
    kbar = jnp.mean(kb.astype(jnp.float32), axis=3)
    qblk = jnp.arange(S) // MOBA_BLOCK
    gate = jnp.einsum('bhsd,bhnd->bhsn', q.astype(jnp.float32), kbar)
    past = jnp.arange(nb)[None, :] < qblk[:, None]
    gate = jnp.where(past, gate, -jnp.inf)
    kk = min(MOBA_TOPK, nb)
    _, idx = lax.top_k(gate, kk)

    nc = S // MOBA_Q_CHUNK
    qc = jnp.moveaxis(q.reshape(B, H, nc, MOBA_Q_CHUNK, D), 2, 0)
    ic = jnp.moveaxis(idx.reshape(B, H, nc, MOBA_Q_CHUNK, kk), 2, 0)
    bi = jnp.arange(B)[:, None, None, None]
    hi = jnp.arange(H)[None, :, None, None]
    scale = D ** -0.5
    offs = jnp.arange(MOBA_BLOCK)

    def chunk(args):
        q_c, idx_c, c = args
        q0 = c * MOBA_Q_CHUNK
        j = q0 // MOBA_BLOCK
        k_sel = kb[bi, hi, idx_c]
        v_sel = vb[bi, hi, idx_c]
        s_sel = jnp.einsum('bhqd,bhqnkd->bhqnk', q_c, k_sel).astype(jnp.float32) * scale
        valid = jnp.arange(kk) < j
        s_sel = jnp.where(valid[None, None, None, :, None], s_sel, -jnp.inf)
        k_own = lax.dynamic_slice_in_dim(kp, j * MOBA_BLOCK, MOBA_BLOCK, axis=2)
        v_own = lax.dynamic_slice_in_dim(vp, j * MOBA_BLOCK, MOBA_BLOCK, axis=2)
        s_own = jnp.einsum('bhqd,bhkd->bhqk', q_c, k_own).astype(jnp.float32) * scale
        qpos = q0 + jnp.arange(MOBA_Q_CHUNK)
        kpos = j * MOBA_BLOCK + offs
        s_own = jnp.where(kpos[None, :] <= qpos[:, None], s_own, -jnp.inf)
        s_all = jnp.concatenate([s_sel.reshape(B, H, MOBA_Q_CHUNK, kk * MOBA_BLOCK), s_own], axis=-1)
        p = jax.nn.softmax(s_all, axis=-1).astype(v.dtype)
        p_sel = p[..., :kk * MOBA_BLOCK].reshape(B, H, MOBA_Q_CHUNK, kk, MOBA_BLOCK)
        p_own = p[..., kk * MOBA_BLOCK:]
        return (jnp.einsum('bhqnk,bhqnkd->bhqd', p_sel, v_sel)
                + jnp.einsum('bhqk,bhkd->bhqd', p_own, v_own))

    out = lax.map(chunk, (qc, ic, jnp.arange(nc)))
    return jnp.moveaxis(out, 0, 2).reshape(B, H, S, D)


def even_mixer(h, w_in, w_out, qn_g, kn_g, lq1, lk1, lq2, lk2, subln_g, mqn_g, mkn_g, lambda_init):
    B, S, _ = h.shape
    nd = N_HEADS_DIFF * HEAD_DIM
    nm = N_HEADS_MOBA * HEAD_DIM
    proj = h @ w_in
    dq, dk, dv, mq, mk, mv = jnp.split(proj, [nd, 2 * nd, 3 * nd, 3 * nd + nm, 3 * nd + 2 * nm], axis=-1)
    cos32, sin32 = rope_tables(DIFF_HALF)
    dq = dq.reshape(B, S, N_HEADS_DIFF, 2, DIFF_HALF).transpose(0, 2, 3, 1, 4)
    dk = dk.reshape(B, S, N_HEADS_DIFF, 2, DIFF_HALF).transpose(0, 2, 3, 1, 4)
    dq = apply_rope(rms_norm(dq, qn_g), cos32, sin32)
    dk = apply_rope(rms_norm(dk, kn_g), cos32, sin32)
    dv = dv.reshape(B, S, N_HEADS_DIFF, HEAD_DIM).transpose(0, 2, 1, 3)
    f32 = jnp.float32
    lam = (jnp.exp(jnp.sum(lq1.astype(f32) * lk1.astype(f32)))
           - jnp.exp(jnp.sum(lq2.astype(f32) * lk2.astype(f32))) + lambda_init)
    a = diff_attention(dq, dk, dv, lam)
    a = rms_norm(a, subln_g) * (1.0 - lambda_init)
    cos64, sin64 = rope_tables(HEAD_DIM)
    mq = mq.reshape(B, S, N_HEADS_MOBA, HEAD_DIM).transpose(0, 2, 1, 3)
    mk = mk.reshape(B, S, N_HEADS_MOBA, HEAD_DIM).transpose(0, 2, 1, 3)
    mv = mv.reshape(B, S, N_HEADS_MOBA, HEAD_DIM).transpose(0, 2, 1, 3)
    mq = apply_rope(rms_norm(mq, mqn_g), cos64, sin64)
    mk = apply_rope(rms_norm(mk, mkn_g), cos64, sin64)
    m = moba_attention(mq, mk, mv)
    out = jnp.concatenate([a, m], axis=1)
    out = out.transpose(0, 2, 1, 3).reshape(B, S, EVEN_OUT)
    return out @ w_out


def odd_mixer(h, w_in, b_in, w_out, ln_g, ln_b, w_s, b_s, conv_w, conv_b, cln_g, cln_b):
    B, S, _ = h.shape
    proj = h @ w_in + b_in
    gz, ca, cg = jnp.split(proj, [2 * GMLP_WIDTH, 2 * GMLP_WIDTH + CONV_CH], axis=-1)
    gu, gv = jnp.split(jax.nn.gelu(gz), 2, axis=-1)
    gv = layer_norm(gv, ln_g, ln_b)
    nc = S // GMLP_CHUNK
    gvc = gv.reshape(B, nc, GMLP_CHUNK, GMLP_GROUPS, GMLP_WIDTH // GMLP_GROUPS)
    tri = jnp.tril(jnp.ones((GMLP_CHUNK, GMLP_CHUNK), dtype=bool))
    wm = jnp.where(tri[None], w_s, jnp.zeros_like(w_s))
    sg = jnp.einsum('gts,bcsgd->bctgd', wm, gvc) + b_s.T[None, None, :, :, None]
    c_out = gu * sg.reshape(B, S, GMLP_WIDTH)
    c = ca * jax.nn.sigmoid(cg)
    c = lax.conv_general_dilated(c, conv_w[:, None, :], window_strides=(1,),
                                 padding=[(CONV_KERNEL - 1, 0)],
                                 dimension_numbers=('NWC', 'WIO', 'NWC'),
                                 feature_group_count=CONV_CH) + conv_b
    d_out = jax.nn.silu(layer_norm(c, cln_g, cln_b))
    return jnp.concatenate([c_out, d_out], axis=-1) @ w_out


def swiglu(h, w_in, w_out):
    g, u = jnp.split(h @ w_in, 2, axis=-1)
    return (jax.nn.silu(g) * u) @ w_out


def setup_inputs(seed: int = 0) -> dict:
    key = jax.random.key(seed)
    ks = jax.random.split(key, 32)

    def nrm(k, shape, scale):
        return jax.random.normal(k, shape, jnp.float32) * scale

    return {
        "x": nrm(ks[0], (BATCH, SEQ, D_MODEL), 1.0),
        "attn_norm_g": 1.0 + nrm(ks[1], (DEPTH, D_MODEL), 0.02),
        "ffn_norm_g": 1.0 + nrm(ks[2], (DEPTH, D_MODEL), 0.02),
        "ffn_w_in": nrm(ks[3], (DEPTH, D_MODEL, 2 * D_FF), D_MODEL ** -0.5),
        "ffn_w_out": nrm(ks[4], (DEPTH, D_FF, D_MODEL), D_FF ** -0.5),
        "even_w_in": nrm(ks[5], (N_EVEN, D_MODEL, EVEN_IN), D_MODEL ** -0.5),
        "even_w_out": nrm(ks[6], (N_EVEN, EVEN_OUT, D_MODEL), EVEN_OUT ** -0.5),
        "diff_q_norm_g": 1.0 + nrm(ks[7], (N_EVEN, DIFF_HALF), 0.02),
        "diff_k_norm_g": 1.0 + nrm(ks[8], (N_EVEN, DIFF_HALF), 0.02),
        "diff_lambda_q1": nrm(ks[9], (N_EVEN, DIFF_HALF), 0.1),
        "diff_lambda_k1": nrm(ks[10], (N_EVEN, DIFF_HALF), 0.1),
        "diff_lambda_q2": nrm(ks[11], (N_EVEN, DIFF_HALF), 0.1),
        "diff_lambda_k2": nrm(ks[12], (N_EVEN, DIFF_HALF), 0.1),
        "diff_subln_g": 1.0 + nrm(ks[13], (N_EVEN, HEAD_DIM), 0.02),
        "moba_q_norm_g": 1.0 + nrm(ks[14], (N_EVEN, HEAD_DIM), 0.02),
        "moba_k_norm_g": 1.0 + nrm(ks[15], (N_EVEN, HEAD_DIM), 0.02),
        "odd_w_in": nrm(ks[16], (N_ODD, D_MODEL, ODD_IN), D_MODEL ** -0.5),
        "odd_b_in": nrm(ks[17], (N_ODD, ODD_IN), 0.02),
        "odd_w_out": nrm(ks[18], (N_ODD, ODD_OUT, D_MODEL), ODD_OUT ** -0.5),
        "gmlp_ln_g": 1.0 + nrm(ks[19], (N_ODD, GMLP_WIDTH), 0.02),
        "gmlp_ln_b": nrm(ks[20], (N_ODD, GMLP_WIDTH), 0.02),
        "gmlp_w_s": nrm(ks[21], (N_ODD, GMLP_GROUPS, GMLP_CHUNK, GMLP_CHUNK), GMLP_CHUNK ** -0.5),
        "gmlp_b_s": 1.0 + nrm(ks[22], (N_ODD, GMLP_GROUPS, GMLP_CHUNK), 0.02),
        "conv_w": nrm(ks[23], (N_ODD, CONV_KERNEL, CONV_CH), CONV_KERNEL ** -0.5),
        "conv_b": nrm(ks[24], (N_ODD, CONV_CH), 0.02),
        "conv_ln_g": 1.0 + nrm(ks[25], (N_ODD, CONV_CH), 0.02),
        "conv_ln_b": nrm(ks[26], (N_ODD, CONV_CH), 0.02),
    }


def reference(x, attn_norm_g, ffn_norm_g, ffn_w_in, ffn_w_out, even_w_in, even_w_out,
              diff_q_norm_g, diff_k_norm_g, diff_lambda_q1, diff_lambda_k1,
              diff_lambda_q2, diff_lambda_k2, diff_subln_g, moba_q_norm_g, moba_k_norm_g,
              odd_w_in, odd_b_in, odd_w_out, gmlp_ln_g, gmlp_ln_b, gmlp_w_s, gmlp_b_s,
              conv_w, conv_b, conv_ln_g, conv_ln_b):
    for i in range(DEPTH):
        h = rms_norm(x, attn_norm_g[i])
        if i % 2 == 0:
            e = i // 2
            lambda_init = 0.8 - 0.6 * math.exp(-0.3 * i)
            mix = even_mixer(h, even_w_in[e], even_w_out[e], diff_q_norm_g[e], diff_k_norm_g[e],
                             diff_lambda_q1[e], diff_lambda_k1[e], diff_lambda_q2[e], diff_lambda_k2[e],
                             diff_subln_g[e], moba_q_norm_g[e], moba_k_norm_g[e], lambda_init)
        else:
            o = i // 2
            mix = odd_mixer(h, odd_w_in[o], odd_b_in[o], odd_w_out[o], gmlp_ln_g[o], gmlp_ln_b[o],
                            gmlp_w_s[o], gmlp_b_s[o], conv_w[o], conv_b[o], conv_ln_g[o], conv_ln_b[o])
        x = x + mix
        x = x + swiglu(rms_norm(x, ffn_norm_g[i]), ffn_w_in[i], ffn_w_out[i])
    return x
```

```cpp
#include <hip/hip_runtime.h>
#include <hip/hip_cooperative_groups.h>
#include <hip/hip_bf16.h>
#include <cstdio>
#include <cstdint>
namespace cg = cooperative_groups;
namespace pg8 {
#define PG8_LAS __attribute__((address_space(3)))
typedef unsigned short bf16_t;
typedef short bf16x8 __attribute__((ext_vector_type(8)));
typedef float f32x4 __attribute__((ext_vector_type(4)));
typedef unsigned u32x4 __attribute__((ext_vector_type(4)));
constexpr int BM = 256, BK = 64, HALF = 128, HTB = HALF * BK * 2  , STAGE_BYTES = 8 * HTB, NXCD = 8, WGM = 8;

__host__ __device__ __forceinline__ int lds_byte(int r, int c) { const int st = (r >> 4) * 2 + (c >> 5), rr = r & 15, cc = c & 31, ob = rr * 64 + cc * 2; return st * 1024 + (ob ^ (((ob >> 9) & 1) << 5)); }
__host__ __device__ __forceinline__ void stage_rc(int b, int& R, int& C) { const int st = b / 1024, sb = b % 1024, swz = sb ^ (((sb >> 9) & 1) << 5); R = (st >> 1) * 16 + swz / 64; C = (st & 1) * 32 + (swz % 64) / 2; }
__host__ __device__ __forceinline__ int perm32(int rho) { const int n = rho >> 4, i = rho & 15; return 8 * (i >> 2) + 4 * n + (i & 3); }

struct Unit { int pm, pn; };
struct Gemm { const bf16_t* A; const bf16_t* Bt; int M, N, K; };

struct StaticOrder {
    int nM, nN, nwg, G, c;
    __host__ __device__ void init(int M, int N, int G_, int c_) { nM = M / BM; nN = N / BM; nwg = nM * nN; G = G_; c = c_; }
    __host__ __device__ bool next(int i, Unit& u) const {
        const long L = (long)i * G + c; if (L >= nwg) return false;
        int wgid = (int)L; { const int q = nwg / NXCD, r = nwg % NXCD, xcd = wgid % NXCD, off = wgid / NXCD; wgid = (xcd < r ? xcd * (q + 1) : r * (q + 1) + (xcd - r) * q) + off; }
        const int nig = WGM * nN, gid = wgid / nig, fm = gid * WGM, gsz = (nM - fm) < WGM ? (nM - fm) : WGM;
        u.pm = fm + ((wgid % nig) % gsz); u.pn = (wgid % nig) / gsz; return true;
    }
    __device__ __forceinline__ void a_ready(const Unit&) const {}
    __device__ __forceinline__ void done(const Unit&) const {}
};

__device__ __forceinline__ unsigned cvt_pk_bf16(float lo, float hi) { unsigned r; asm volatile("v_cvt_pk_bf16_f32 %0, %1, %2" : "=v"(r) : "v"(lo), "v"(hi)); return r; }
typedef float f32x2 __attribute__((ext_vector_type(2)));
__device__ __forceinline__ f32x2 gelu_pk(f32x2 v) {
    const f32x2 av = __builtin_elementwise_abs(v), d = av * 0.2316418882f + 1.0f;
    f32x2 t; t.x = __builtin_amdgcn_rcpf(d.x); t.y = __builtin_amdgcn_rcpf(d.y);
    f32x2 q = t * 0.5307027145f + (-0.7265760135f); q = q * t + 0.7107068705f; q = q * t + (-0.142248368f); q = q * t + 0.127414796f; q = q * t;
    const f32x2 s = (v * v) * (-0.72134752044f);
    f32x2 e; e.x = __builtin_amdgcn_exp2f(s.x); e.y = __builtin_amdgcn_exp2f(s.y);
    const f32x2 m = v * (q * e), r = v - m;
    f32x2 o; o.x = v.x < 0.f ? m.x : r.x; o.y = v.y < 0.f ? m.y : r.y; return o;
}

template <int ACT  > struct EpiBf16 {
    static constexpr bool PERM = true, AFTER_DRAIN = false; static_assert(ACT == 0 || ACT == 1, "EpiBf16: ACT is 0 (none) or 1 (gelu_pk)");
    bf16_t* O; int ldc; const float* bias; int split_cols; size_t split_stride; float scale0;
    __device__ __forceinline__ void operator()(const f32x4 (&acc)[2][2][4][2], const Unit& u, int wr, int wc, int fr, int fq) const {
        const int row0 = u.pm * BM + wr * 64 + fr; int colt = u.pn * BM; bf16_t* base = O;
        float sc = 1.f; if (split_cols) { const int t = colt / split_cols; base += (size_t)t * split_stride; colt -= t * split_cols; if (t == 0) sc = scale0; }
        const int col0 = colt + wc * 32 + 8 * fq, bcol0 = u.pn * BM + wc * 32 + 8 * fq;
        f32x4 bv[2][2];
#pragma unroll
        for (int bj = 0; bj < 2; ++bj)
#pragma unroll
            for (int n = 0; n < 2; ++n) bv[bj][n] = bias ? *(const f32x4*)(bias + bcol0 + bj * HALF + 4 * n) : (f32x4){0.f, 0.f, 0.f, 0.f};
#pragma unroll
        for (int ai = 0; ai < 2; ++ai)
#pragma unroll
            for (int m = 0; m < 4; ++m) { bf16_t* rowp = base + (size_t)(row0 + ai * HALF + m * 16) * ldc + col0;
#pragma unroll
                for (int bj = 0; bj < 2; ++bj) { f32x4 v0 = acc[ai][bj][m][0] + bv[bj][0], v1 = acc[ai][bj][m][1] + bv[bj][1];
                    if (ACT == 1) { f32x2 a = gelu_pk((f32x2){v0[0], v0[1]}), b = gelu_pk((f32x2){v0[2], v0[3]}), c = gelu_pk((f32x2){v1[0], v1[1]}), d = gelu_pk((f32x2){v1[2], v1[3]});
                        v0 = (f32x4){a.x, a.y, b.x, b.y}; v1 = (f32x4){c.x, c.y, d.x, d.y}; }
                    v0 = v0 * sc; v1 = v1 * sc; u32x4 w; w.x = cvt_pk_bf16(v0[0], v0[1]); w.y = cvt_pk_bf16(v0[2], v0[3]); w.z = cvt_pk_bf16(v1[0], v1[1]); w.w = cvt_pk_bf16(v1[2], v1[3]);
                    *(u32x4*)(rowp + bj * HALF) = w; } }
    }
};

struct PanelStats {
    unsigned* xbuf;
    unsigned* cnt;
    unsigned* tmo;
    int ntn; float eps;
    unsigned code;
    __device__ __forceinline__ bool run(const f32x4 (&v)[2][2][4][2], const Unit& u, int wr, int wc, int fr, int fq, PG8_LAS unsigned char* lds, int wid, int lane) const {
        typedef float f32x2v __attribute__((ext_vector_type(2)));
        PG8_LAS f32x2v* P = (PG8_LAS f32x2v*)lds;
        PG8_LAS f32x2v* S = (PG8_LAS f32x2v*)(lds + 8192);
        PG8_LAS unsigned* flag = (PG8_LAS unsigned*)(lds + 8192 + 2048);
#pragma unroll
        for (int ai = 0; ai < 2; ++ai)
#pragma unroll
            for (int m = 0; m < 4; ++m) {
                float s = 0.f;
#pragma unroll
                for (int bj = 0; bj < 2; ++bj)
#pragma unroll
                    for (int n = 0; n < 2; ++n) { const f32x4 x = v[ai][bj][m][n]; s += (x[0] + x[1]) + (x[2] + x[3]); }
                s += __shfl_xor(s, 16); s += __shfl_xor(s, 32);
                const float mw = s * (1.0f / 64.0f); float q = 0.f;
#pragma unroll
                for (int bj = 0; bj < 2; ++bj)
#pragma unroll
                    for (int n = 0; n < 2; ++n) { const f32x4 d = v[ai][bj][m][n] - mw; q += (d[0] * d[0] + d[1] * d[1]) + (d[2] * d[2] + d[3] * d[3]); }
                q += __shfl_xor(q, 16); q += __shfl_xor(q, 32);
                if (fq == 0) P[(ai * HALF + wr * 64 + m * 16 + fr) * 4 + wc] = (f32x2v){mw, q};
            }
        asm volatile("s_waitcnt lgkmcnt(0)" ::: "memory"); __builtin_amdgcn_s_barrier(); asm volatile("" ::: "memory");
#if defined(BROKEN_EXCHANGE_NO_WAIT)
#warning BROKEN CONTROL BUILD: the row-statistics exchange does not wait; results are wrong by design
        if (blockIdx.x >= 64) { const long long t0_ = clock64(); while (clock64() - t0_ < 60000) __builtin_amdgcn_s_sleep(8); }
#endif
        const int row = wid * 32 + (lane & 31);
        if (lane < 32) {
            const f32x2v a = P[row * 4 + 0], b = P[row * 4 + 1], c = P[row * 4 + 2], d = P[row * 4 + 3];
            const float mt = (a.x + b.x + c.x + d.x) * 0.25f;
            const float da = a.x - mt, db = b.x - mt, dc = c.x - mt, dd = d.x - mt;
            const float m2 = (a.y + b.y) + (c.y + d.y) + 64.0f * ((da * da + db * db) + (dc * dc + dd * dd));
            unsigned long long* slot = (unsigned long long*)xbuf + ((size_t)(u.pm * BM + row) * 4 + u.pn);
            __hip_atomic_store(slot, ((unsigned long long)__float_as_uint(m2) << 32) | __float_as_uint(mt), __ATOMIC_RELAXED, __HIP_MEMORY_SCOPE_AGENT);
        }
        asm volatile("s_waitcnt vmcnt(0)" ::: "memory");
        if (lane == 0) __hip_atomic_fetch_add(cnt + 64 * u.pm, 1u, __ATOMIC_RELAXED, __HIP_MEMORY_SCOPE_AGENT);
        if (wid == 0) {
            bool dead = false; const unsigned long long t0 = __builtin_amdgcn_s_memrealtime(); const unsigned want = 8u * (unsigned)ntn;
            for (;;) {
#if defined(BROKEN_EXCHANGE_NO_WAIT)
                break;
#endif
                if ((unsigned)__builtin_amdgcn_readfirstlane(__hip_atomic_load(cnt + 64 * u.pm, __ATOMIC_RELAXED, __HIP_MEMORY_SCOPE_AGENT)) >= want) break;
                if (__builtin_amdgcn_s_memrealtime() - t0 > 2000000ull) {
                    if (lane == 0) { unsigned expect = 0u; __hip_atomic_compare_exchange_strong(tmo + 1, &expect, code | (unsigned)(u.pm & 0xff), __ATOMIC_RELAXED, __ATOMIC_RELAXED, __HIP_MEMORY_SCOPE_AGENT);
                                     __hip_atomic_store(tmo, 1u, __ATOMIC_RELAXED, __HIP_MEMORY_SCOPE_AGENT); }
                    dead = true; break; }
                __builtin_amdgcn_s_sleep(2);
            }
            __builtin_amdgcn_fence(__ATOMIC_ACQUIRE, "agent");
            if (lane == 0) flag[0] = dead ? 1u : 0u;
        }
        asm volatile("s_waitcnt vmcnt(0) lgkmcnt(0)" ::: "memory"); __builtin_amdgcn_s_barrier(); asm volatile("" ::: "memory");
        const bool bad = flag[0] != 0u;
        if (lane < 32) {
            const unsigned long long* slot = (const unsigned long long*)xbuf + (size_t)(u.pm * BM + row) * 4; float mt[4], m2[4]; float ms = 0.f;
#pragma unroll
            for (int t = 0; t < 4; ++t) { if (t < ntn) { const unsigned long long w = __hip_atomic_load(slot + t, __ATOMIC_RELAXED, __HIP_MEMORY_SCOPE_AGENT); mt[t] = __uint_as_float((unsigned)w); m2[t] = __uint_as_float((unsigned)(w >> 32)); } else { mt[t] = 0.f; m2[t] = 0.f; } ms += mt[t]; }
            const float mean = ms / (float)ntn; float q = 0.f;
#pragma unroll
            for (int t = 0; t < 4; ++t) if (t < ntn) { const float dm = mt[t] - mean; q += m2[t] + 256.0f * dm * dm; }
            S[row] = (f32x2v){mean, 1.0f / sqrtf(q / (256.0f * (float)ntn) + eps)};
        }
        asm volatile("s_waitcnt lgkmcnt(0)" ::: "memory"); __builtin_amdgcn_s_barrier(); asm volatile("" ::: "memory");
        return bad;
    }
};
struct EpiLnRes {
    static constexpr bool PERM = false, AFTER_DRAIN = true;
    const float* base; float* out; int ldc; const float* bias; PanelStats st; unsigned poison;
    __device__ __forceinline__ void fused(f32x4 (&acc)[2][2][4][2], const Unit& u, int wr, int wc, int fr, int fq, PG8_LAS unsigned char* lds, int wid, int lane) const {
        typedef float f32x2v __attribute__((ext_vector_type(2)));
        const PG8_LAS f32x2v* S = (const PG8_LAS f32x2v*)(lds + 8192);
        const int col0 = u.pn * BM + wc * 32 + 4 * fq;
#pragma unroll
        for (int bj = 0; bj < 2; ++bj)
#pragma unroll
            for (int n = 0; n < 2; ++n) { const f32x4 bv = bias ? *(const f32x4*)(bias + col0 + bj * HALF + n * 16) : (f32x4){0.f, 0.f, 0.f, 0.f};
#pragma unroll
                for (int ai = 0; ai < 2; ++ai)
#pragma unroll
                    for (int m = 0; m < 4; ++m) acc[ai][bj][m][n] += bv; }
        f32x4 pre[4][2][2];
#pragma unroll
        for (int m = 0; m < 4; ++m) { const size_t off = (size_t)(u.pm * BM + wr * 64 + m * 16 + fr) * ldc + col0;
#pragma unroll
            for (int bj = 0; bj < 2; ++bj)
#pragma unroll
                for (int n = 0; n < 2; ++n) pre[m][bj][n] = *(const f32x4*)(base + off + bj * HALF + n * 16); }
        const bool bad = st.run(acc, u, wr, wc, fr, fq, lds, wid, lane) || poison != 0u;
        const float qnan = __builtin_nanf("");
#pragma unroll
        for (int ai = 0; ai < 2; ++ai)
#pragma unroll
            for (int m = 0; m < 4; ++m) { const int r = ai * HALF + wr * 64 + m * 16 + fr; const f32x2v sr = S[r]; const size_t off = (size_t)(u.pm * BM + r) * ldc + col0;
#pragma unroll
                for (int bj = 0; bj < 2; ++bj)
#pragma unroll
                    for (int n = 0; n < 2; ++n) { const f32x4 bs = ai == 0 ? pre[m][bj][n] : *(const f32x4*)(base + off + bj * HALF + n * 16); f32x4 o = bs + (acc[ai][bj][m][n] - sr.x) * sr.y;
                        if (bad) o = (f32x4){qnan, qnan, qnan, qnan}; *(f32x4*)(out + off + bj * HALF + n * 16) = o; }
                if (m & 1) asm volatile("" ::: "memory"); }
    }
};
struct EpiLnResLn {
    static constexpr bool PERM = false, AFTER_DRAIN = true;
    const float* base; float* out; bf16_t* xn; int ldc; const float* bias; PanelStats st1, st2; unsigned poison;
    __device__ __forceinline__ void fused(f32x4 (&acc)[2][2][4][2], const Unit& u, int wr, int wc, int fr, int fq, PG8_LAS unsigned char* lds, int wid, int lane) const {
        typedef float f32x2v __attribute__((ext_vector_type(2))); typedef unsigned u32x2v __attribute__((ext_vector_type(2)));
        const PG8_LAS f32x2v* S = (const PG8_LAS f32x2v*)(lds + 8192);
        const int col0 = u.pn * BM + wc * 32 + 4 * fq;
#pragma unroll
        for (int bj = 0; bj < 2; ++bj)
#pragma unroll
            for (int n = 0; n < 2; ++n) { const f32x4 bv = bias ? *(const f32x4*)(bias + col0 + bj * HALF + n * 16) : (f32x4){0.f, 0.f, 0.f, 0.f};
#pragma unroll
                for (int ai = 0; ai < 2; ++ai)
#pragma unroll
                    for (int m = 0; m < 4; ++m) acc[ai][bj][m][n] += bv; }
        bool bad = st1.run(acc, u, wr, wc, fr, fq, lds, wid, lane) || poison != 0u;
        const float qnan = __builtin_nanf("");
#pragma unroll
        for (int ai = 0; ai < 2; ++ai)
#pragma unroll
            for (int m = 0; m < 4; ++m) { const int r = ai * HALF + wr * 64 + m * 16 + fr; const f32x2v sr = S[r]; const size_t off = (size_t)(u.pm * BM + r) * ldc + col0;
#pragma unroll
                for (int bj = 0; bj < 2; ++bj)
#pragma unroll
                    for (int n = 0; n < 2; ++n) { const f32x4 bs = *(const f32x4*)(base + off + bj * HALF + n * 16); acc[ai][bj][m][n] = bs + (acc[ai][bj][m][n] - sr.x) * sr.y; }
                asm volatile("" : "+v"(acc[ai][0][m][0]), "+v"(acc[ai][0][m][1]), "+v"(acc[ai][1][m][0]), "+v"(acc[ai][1][m][1]));
                if (m & 1) asm volatile("" ::: "memory"); }
        const bool bad1 = bad;
        bad = st2.run(acc, u, wr, wc, fr, fq, lds, wid, lane) || bad;
#pragma unroll
        for (int ai = 0; ai < 2; ++ai)
#pragma unroll
            for (int m = 0; m < 4; ++m) { const int r = ai * HALF + wr * 64 + m * 16 + fr; const f32x2v sr = S[r]; const size_t off = (size_t)(u.pm * BM + r) * ldc + col0;
#pragma unroll
                for (int bj = 0; bj < 2; ++bj)
#pragma unroll
                    for (int n = 0; n < 2; ++n) { const f32x4 x1 = acc[ai][bj][m][n]; *(f32x4*)(out + off + bj * HALF + n * 16) = bad1 ? (f32x4){qnan, qnan, qnan, qnan} : x1;
                        const f32x4 o = (x1 - sr.x) * sr.y; u32x2v w; w.x = cvt_pk_bf16(o[0], o[1]); w.y = cvt_pk_bf16(o[2], o[3]);
                        if (bad) { w.x = 0x7fc07fc0u; w.y = 0x7fc07fc0u; } *(u32x2v*)(xn + off + bj * HALF + n * 16) = w; }
                asm volatile("" ::: "memory"); }
    }
};

template <class Epi, class Sched, bool ALIGN_EPI = false, bool SP2 = false>
__device__ __forceinline__ void gemm_phase(PG8_LAS unsigned char* lds, const Gemm g, const Sched& S, const Epi& E, int wid_s) {
    int lane_; asm volatile("v_mbcnt_lo_u32_b32 %0, -1, 0\n\tv_mbcnt_hi_u32_b32 %0, -1, %0" : "=v"(lane_));
    const int tid = wid_s * 64 + lane_, wid = wid_s, lane = tid & 63, wr = wid >> 2, wc = wid & 3, fr = lane & 15, fq = lane >> 4;
    const int K = g.K, nt = K / BK;
    unsigned voffA[2], voffB[2];
#pragma unroll
    for (int i = 0; i < 2; ++i) { int R, C; stage_rc(tid * 16 + i * 8192, R, C); const int Rb = Epi::PERM ? ((R & ~31) + perm32(R & 31)) : R;
        voffA[i] = (unsigned)(R * K + C) * 2u; voffB[i] = (unsigned)(Rb * K + C) * 2u; }
    const size_t kstep = (size_t)(BK * 2);
    const size_t hstep = (size_t)HALF * K * 2;
    const size_t tstep = 2 * hstep;
    const unsigned ldsw = (unsigned)wid * 1024u;
    const int aoff = lds_byte(wr * 64 + fr, fq * 8), boff = lds_byte(wc * 32 + fr, fq * 8);
#define PG8_SA(b, h) (((b) * 2 + (h)) * HTB)
#define PG8_SB(b, h) ((4 + (b) * 2 + (h)) * HTB)
#define PG8_STAGE(bufoff, gbase, voff) do { _Pragma("unroll") for (int _i = 0; _i < 2; ++_i) \
        __builtin_amdgcn_global_load_lds((const unsigned*)((const char*)(gbase) + (voff)[_i]), (PG8_LAS unsigned*)(lds + (bufoff) + ldsw + _i * 8192), 16, 0, 0); } while (0)
#define PG8_LDA(dst, b, h) do { _Pragma("unroll") for (int m = 0; m < 4; ++m) _Pragma("unroll") for (int k = 0; k < 2; ++k) dst[m][k] = *(const PG8_LAS bf16x8*)(lds + PG8_SA(b, h) + aoff + m * 2048 + k * 1024); } while (0)
#define PG8_LDB(dst, b, h) do { _Pragma("unroll") for (int n = 0; n < 2; ++n) _Pragma("unroll") for (int k = 0; k < 2; ++k) dst[n][k] = *(const PG8_LAS bf16x8*)(lds + PG8_SB(b, h) + boff + n * 2048 + k * 1024); } while (0)
#define PG8_MMA(ai, bj, At, Bt) do { __builtin_amdgcn_s_setprio(1); _Pragma("unroll") for (int m = 0; m < 4; ++m) _Pragma("unroll") for (int n = 0; n < 2; ++n) _Pragma("unroll") for (int k = 0; k < 2; ++k) \
        acc[ai][bj][m][n] = __builtin_amdgcn_mfma_f32_16x16x32_bf16(Bt[n][k], At[m][k], acc[ai][bj][m][n], 0, 0, 0); __builtin_amdgcn_s_setprio(0); } while (0)
#define PG8_WAIT_V(n) asm volatile("s_waitcnt vmcnt(" #n ")" ::: "memory")
#define PG8_WAIT_L(n) asm volatile("s_waitcnt lgkmcnt(" #n ")" ::: "memory")
#define PG8_BAR __builtin_amdgcn_s_barrier()
#define PG8_SCHED __builtin_amdgcn_sched_barrier(0)
    Unit cur, nxt; int ui = 0;
    if (!S.next(0, cur)) return;
    f32x4 acc[2][2][4][2];
#pragma unroll
    for (int a = 0; a < 2; ++a)
#pragma unroll
        for (int b = 0; b < 2; ++b)
#pragma unroll
            for (int m = 0; m < 4; ++m)
#pragma unroll
                for (int n = 0; n < 2; ++n) acc[a][b][m][n] = (f32x4){0.f, 0.f, 0.f, 0.f};
    bf16x8 At[4][2], B0[2][2], B1[2][2];
    const char* cA = (const char*)g.A + (size_t)cur.pm * tstep; const char* cB = (const char*)g.Bt + (size_t)cur.pn * tstep;
    S.a_ready(cur);
    if constexpr (SP2) {
        PG8_STAGE(PG8_SB(0, 0), cB, voffB); PG8_STAGE(PG8_SB(0, 1), cB + hstep, voffB); PG8_STAGE(PG8_SA(0, 0), cA, voffA); PG8_STAGE(PG8_SA(0, 1), cA + hstep, voffA);
        if (wr == 1) PG8_BAR;
        PG8_WAIT_V(2); PG8_BAR;
        PG8_STAGE(PG8_SB(1, 0), cB + kstep, voffB); PG8_STAGE(PG8_SA(1, 0), cA + kstep, voffA); PG8_STAGE(PG8_SB(1, 1), cB + hstep + kstep, voffB);
        PG8_WAIT_V(6); PG8_BAR;
    } else {
        PG8_STAGE(PG8_SB(0, 0), cB, voffB); PG8_STAGE(PG8_SA(0, 0), cA, voffA); PG8_STAGE(PG8_SB(0, 1), cB + hstep, voffB); PG8_STAGE(PG8_SA(0, 1), cA + hstep, voffA);
        if (wr == 1) PG8_BAR;
        PG8_WAIT_V(4); PG8_BAR;
        PG8_STAGE(PG8_SB(1, 0), cB + kstep, voffB); PG8_STAGE(PG8_SA(1, 0), cA + kstep, voffA); PG8_STAGE(PG8_SB(1, 1), cB + hstep + kstep, voffB);
        PG8_WAIT_V(6); PG8_BAR;
    }
    for (;;) {
        const bool has_next = S.next(ui + 1, nxt);
        const char* nA = has_next ? (const char*)g.A + (size_t)nxt.pm * tstep : cA; const char* nB = has_next ? (const char*)g.Bt + (size_t)nxt.pn * tstep : cB;
        for (int t = 0; t < nt; t += 2) {
            const bool last = (t == nt - 2);
            const char* a1 = cA + (size_t)(t + 1) * kstep;
            const char* a2 = last ? nA : cA + (size_t)(t + 2) * kstep; const char* b2 = last ? nB : cB + (size_t)(t + 2) * kstep;
            const char* a3 = a2 + kstep; const char* b3 = b2 + kstep;
            if (last && has_next) S.a_ready(nxt);
            if constexpr (SP2) {
            PG8_LDB(B0, 0, 0); PG8_LDB(B1, 0, 1); PG8_SCHED; PG8_LDA(At, 0, 0); PG8_STAGE(PG8_SA(1, 1), a1 + hstep, voffA);
            PG8_WAIT_V(8); PG8_WAIT_L(0); PG8_BAR; PG8_MMA(0, 0, At, B0); PG8_MMA(0, 1, At, B1); PG8_BAR; PG8_SCHED;
            PG8_LDA(At, 0, 1); PG8_STAGE(PG8_SB(0, 0), b2, voffB); PG8_STAGE(PG8_SB(0, 1), b2 + hstep, voffB); PG8_STAGE(PG8_SA(0, 0), a2, voffA);
            PG8_WAIT_V(8); PG8_WAIT_L(0); PG8_BAR; PG8_MMA(1, 0, At, B0); PG8_MMA(1, 1, At, B1); PG8_BAR; PG8_SCHED;
            PG8_LDB(B0, 1, 0); PG8_LDB(B1, 1, 1); PG8_SCHED; PG8_LDA(At, 1, 0); PG8_STAGE(PG8_SA(0, 1), a2 + hstep, voffA);
            PG8_WAIT_V(8); PG8_WAIT_L(0); PG8_BAR; PG8_MMA(0, 0, At, B0); PG8_MMA(0, 1, At, B1); PG8_BAR; PG8_SCHED;
            PG8_LDA(At, 1, 1); PG8_STAGE(PG8_SB(1, 0), b3, voffB); PG8_STAGE(PG8_SB(1, 1), b3 + hstep, voffB); PG8_STAGE(PG8_SA(1, 0), a3, voffA);
            PG8_WAIT_V(8); PG8_WAIT_L(0); PG8_BAR; PG8_MMA(1, 0, At, B0); PG8_MMA(1, 1, At, B1); PG8_BAR; PG8_SCHED;
            } else {
            PG8_LDB(B0, 0, 0); PG8_SCHED; PG8_LDA(At, 0, 0); PG8_STAGE(PG8_SA(1, 1), a1 + hstep, voffA);
            PG8_WAIT_L(8); PG8_BAR; PG8_WAIT_L(0); PG8_MMA(0, 0, At, B0); PG8_BAR; PG8_SCHED;
            PG8_LDB(B1, 0, 1); PG8_STAGE(PG8_SB(0, 0), b2, voffB);
            PG8_BAR; PG8_WAIT_L(0); PG8_MMA(0, 1, At, B1); PG8_BAR;
            PG8_LDA(At, 0, 1); PG8_STAGE(PG8_SA(0, 0), a2, voffA);
            PG8_BAR; PG8_WAIT_L(0); PG8_MMA(1, 0, At, B0); PG8_BAR; PG8_SCHED;
            PG8_STAGE(PG8_SB(0, 1), b2 + hstep, voffB);
            PG8_WAIT_V(6); PG8_BAR; PG8_MMA(1, 1, At, B1); PG8_BAR;
            PG8_LDB(B0, 1, 0); PG8_SCHED; PG8_LDA(At, 1, 0); PG8_STAGE(PG8_SA(0, 1), a2 + hstep, voffA);
            PG8_WAIT_L(8); PG8_BAR; PG8_WAIT_L(0); PG8_MMA(0, 0, At, B0); PG8_BAR; PG8_SCHED;
            PG8_LDB(B1, 1, 1); PG8_STAGE(PG8_SB(1, 0), b3, voffB);
            PG8_BAR; PG8_WAIT_L(0); PG8_MMA(0, 1, At, B1); PG8_BAR;
            PG8_LDA(At, 1, 1); PG8_STAGE(PG8_SA(1, 0), a3, voffA);
            PG8_BAR; PG8_WAIT_L(0); PG8_MMA(1, 0, At, B0); PG8_BAR; PG8_SCHED;
            PG8_STAGE(PG8_SB(1, 1), b3 + hstep, voffB);
            PG8_WAIT_V(6); PG8_BAR; PG8_MMA(1, 1, At, B1); PG8_BAR;
            }
        }
        if constexpr (ALIGN_EPI) { if (wr == 0) PG8_BAR; }
        if constexpr (!Epi::AFTER_DRAIN) { E(acc, cur, wr, wc, fr, fq); S.done(cur); }
        if (!has_next) break;
#pragma unroll
        for (int a = 0; a < 2; ++a)
#pragma unroll
            for (int b = 0; b < 2; ++b)
#pragma unroll
                for (int m = 0; m < 4; ++m)
#pragma unroll
                    for (int n = 0; n < 2; ++n) acc[a][b][m][n] = (f32x4){0.f, 0.f, 0.f, 0.f};
        cur = nxt; cA = nA; cB = nB; ++ui;
        if constexpr (ALIGN_EPI) { if (wr == 1) PG8_BAR; }
    }
    PG8_WAIT_V(0);
    if constexpr (!ALIGN_EPI) { if (wr == 0) PG8_BAR; }
    PG8_BAR;
    if constexpr (Epi::AFTER_DRAIN) { E.fused(acc, cur, wr, wc, fr, fq, lds, wid, lane); S.done(cur); }
#undef PG8_SA
#undef PG8_SB
#undef PG8_STAGE
#undef PG8_LDA
#undef PG8_LDB
#undef PG8_MMA
#undef PG8_WAIT_V
#undef PG8_WAIT_L
#undef PG8_BAR
#undef PG8_SCHED
}
}

#define LAS __attribute__((address_space(3)))
typedef unsigned short bf16_t;
typedef short bf16x8 __attribute__((ext_vector_type(8)));
typedef short s16x4 __attribute__((ext_vector_type(4)));
typedef float f32x4 __attribute__((ext_vector_type(4)));
typedef float f32x16 __attribute__((ext_vector_type(16)));
typedef unsigned u32x4 __attribute__((ext_vector_type(4)));
typedef unsigned u32x2 __attribute__((ext_vector_type(2)));
typedef float f32x2_t __attribute__((ext_vector_type(2)));
typedef __bf16 bf16x2_t __attribute__((ext_vector_type(2)));

constexpr int MTOK = 16384, DMODEL = 1024, SEQL = 4096, DFF = 2816;
constexpr float EPS = 1e-6f;
constexpr float QSCALE_D = 0.17677669529663687f * 1.4426950408889634f;
constexpr float QSCALE_M = 0.125f * 1.4426950408889634f;
constexpr int LDS_BYTES = 147456;

constexpr size_t KiB = 1024, MiB = 1u << 20;
constexpr size_t WS_SSQ = 0, WS_GVST = 256 * KiB, WS_KBAR = 384 * KiB, WS_PAR = 512 * KiB;
constexpr size_t WS_COS32 = 1 * MiB, WS_SIN32 = 1 * MiB + 256 * KiB, WS_COS64 = 2 * MiB, WS_SIN64 = 2 * MiB + 512 * KiB, WS_WSB = 3 * MiB;
constexpr size_t WS_WEI = 4 * MiB, WS_WEO = 10 * MiB, WS_WFI0 = 12 * MiB, WS_WFI1 = 23 * MiB, WS_WFO0 = 34 * MiB, WS_WFO1 = 34 * MiB + 5632 * KiB;
constexpr size_t WS_WOI = 45 * MiB, WS_WOO = 49 * MiB, WS_XB = 52 * MiB, WS_MIX = 84 * MiB, WS_BIG = 116 * MiB;
constexpr size_t WS_QK = WS_BIG, WS_VT = WS_BIG + 64 * MiB, WS_ACT = WS_BIG, WS_GU = WS_BIG, WS_GV = WS_BIG + 16 * MiB, WS_CP = WS_BIG + 32 * MiB;
constexpr size_t WS_END = 212 * MiB;

struct Args { const float* in[27]; float* out; unsigned char* ws; };

__device__ __forceinline__ unsigned cvtpk(float lo, float hi) { f32x2_t v = {lo, hi}; bf16x2_t b = __builtin_convertvector(v, bf16x2_t); return __builtin_bit_cast(unsigned, b); }
__device__ __forceinline__ bf16_t f2bf(float f) { return (bf16_t)(cvtpk(f, 0.f) & 0xffffu); }
__device__ __forceinline__ float bf2f(bf16_t u) { return __uint_as_float((unsigned)u << 16); }
__device__ __forceinline__ float bflo(unsigned w) { return __uint_as_float(w << 16); }
__device__ __forceinline__ float bfhi(unsigned w) { return __uint_as_float(w & 0xffff0000u); }
__device__ __forceinline__ float dot4(f32x4 a) { return (a[0] * a[0] + a[1] * a[1]) + (a[2] * a[2] + a[3] * a[3]); }
__device__ __forceinline__ float sum4(f32x4 a) { return (a[0] + a[1]) + (a[2] + a[3]); }
__device__ __forceinline__ u32x2 pk4(f32x4 v) { u32x2 w; w.x = cvtpk(v[0], v[1]); w.y = cvtpk(v[2], v[3]); return w; }
__device__ __forceinline__ float wave_sum(float v) {
#pragma unroll
    for (int o = 1; o < 64; o <<= 1) v += __shfl_xor(v, o);
    return v;
}
__device__ __forceinline__ float hswap_max(float v) { auto rr = __builtin_amdgcn_permlane32_swap(__float_as_uint(v), __float_as_uint(v), false, false); return fmaxf(__uint_as_float(rr[0]), __uint_as_float(rr[1])); }
__device__ __forceinline__ float hswap_sum(float v) { auto rr = __builtin_amdgcn_permlane32_swap(__float_as_uint(v), __float_as_uint(v), false, false); return __uint_as_float(rr[0]) + __uint_as_float(rr[1]); }
__device__ __forceinline__ float fast_sigmoid(float x) { return __builtin_amdgcn_rcpf(1.f + __expf(-x)); }
#define MFMA32(a, b, c) __builtin_amdgcn_mfma_f32_32x32x16_bf16((a), (b), (c), 0, 0, 0)
__device__ __forceinline__ int mk_tid(int wid_s) { int lane_; asm volatile("v_mbcnt_lo_u32_b32 %0, -1, 0\n\tv_mbcnt_hi_u32_b32 %0, -1, %0" : "=v"(lane_)); return wid_s * 64 + lane_; }
__device__ __forceinline__ int crow(int reg, int h) { return (reg & 3) + 8 * (reg >> 2) + 4 * h; }


constexpr int PB_QN = 0, PB_KN = 32, PB_MQN = 64, PB_MKN = 128, PB_SUBLN = 192, PB_OBIAS = 256, PB_GLNG = 2304, PB_GLNB = 2816, PB_GBS = 3328, PB_CW = 4352, PB_CB = 20224, PB_CLNG = 20736, PB_CLNB = 21248, PB_LAM = 21760;
struct EpiDiffQK {
    static constexpr bool PERM = false, AFTER_DRAIN = false;
    unsigned char* ws;
    __device__ __forceinline__ void operator()(const f32x4 (&acc)[2][2][4][2], const pg8::Unit& u, int wr, int wc, int fr, int fq) const {
        const int type = u.pn >> 1, head = (u.pn & 1) * 4 + wc;
        const int rowb = u.pm * 256 + wr * 64 + fr;
        const float* ssq = (const float*)(ws + WS_SSQ); bf16_t* QK = (bf16_t*)(ws + WS_QK);
        const float* cos32 = (const float*)(ws + WS_COS32); const float* sin32 = (const float*)(ws + WS_SIN32);
        const float* g = (const float*)(ws + WS_PAR) + (type == 0 ? PB_QN : PB_KN); const float qs = type == 0 ? QSCALE_D : 1.f;
        const f32x4 g0 = *(const f32x4*)(g + 4 * fq), g1 = *(const f32x4*)(g + 16 + 4 * fq);
#pragma unroll
        for (int ai = 0; ai < 2; ++ai)
#pragma unroll
            for (int m = 0; m < 4; ++m) {
                const int row = rowb + ai * 128 + m * 16, t = row & (SEQL - 1);
                const float rs = rsqrtf(ssq[row] * (1.f / DMODEL) + EPS);
                const f32x4 c = *(const f32x4*)(cos32 + t * 16 + 4 * fq), s = *(const f32x4*)(sin32 + t * 16 + 4 * fq);
#pragma unroll
                for (int bj = 0; bj < 2; ++bj) {
                    const f32x4 v0 = acc[ai][bj][m][0] * rs, v1 = acc[ai][bj][m][1] * rs;
                    float ss = dot4(v0) + dot4(v1); ss += __shfl_xor(ss, 16); ss += __shfl_xor(ss, 32);
                    const float r = rsqrtf(ss * (1.f / 32.f) + EPS);
                    const f32x4 y0 = v0 * r * g0, y1 = v1 * r * g1;
                    const f32x4 o0 = (y0 * c - y1 * s) * qs, o1 = (y1 * c + y0 * s) * qs;
                    bf16_t* dst = QK + (size_t)row * 2048 + type * 512 + head * 64 + bj * 32 + 4 * fq;
                    *(u32x2*)dst = pk4(o0); *(u32x2*)(dst + 16) = pk4(o1);
                }
                asm volatile("" ::: "memory");
            }
    }
};
struct EpiMobaQK {
    static constexpr bool PERM = false, AFTER_DRAIN = false;
    unsigned char* ws;
    __device__ __forceinline__ void operator()(const f32x4 (&acc)[2][2][4][2], const pg8::Unit& u, int wr, int wc, int fr, int fq) const {
        const int type = u.pn >> 1, head = (u.pn & 1) * 4 + wc;
        const int rowb = u.pm * 256 + wr * 64 + fr;
        const float* ssq = (const float*)(ws + WS_SSQ); bf16_t* QK = (bf16_t*)(ws + WS_QK);
        const float* cos64 = (const float*)(ws + WS_COS64); const float* sin64 = (const float*)(ws + WS_SIN64);
        const float* g = (const float*)(ws + WS_PAR) + (type == 0 ? PB_MQN : PB_MKN); const float qs = type == 0 ? QSCALE_M : 1.f;
        f32x4 gg[2][2], cs[2][2];
#pragma unroll
        for (int bj = 0; bj < 2; ++bj)
#pragma unroll
            for (int n = 0; n < 2; ++n) { gg[bj][n] = *(const f32x4*)(g + 32 * bj + 16 * n + 4 * fq); cs[bj][n] = (f32x4){0.f, 0.f, 0.f, 0.f}; }
#pragma unroll
        for (int ai = 0; ai < 2; ++ai)
#pragma unroll
            for (int m = 0; m < 4; ++m) {
                const int row = rowb + ai * 128 + m * 16, t = row & (SEQL - 1);
                const float rs = rsqrtf(ssq[row] * (1.f / DMODEL) + EPS);
                f32x4 v[2][2]; float ss = 0.f;
#pragma unroll
                for (int bj = 0; bj < 2; ++bj)
#pragma unroll
                    for (int n = 0; n < 2; ++n) { v[bj][n] = acc[ai][bj][m][n] * rs; ss += dot4(v[bj][n]); }
                ss += __shfl_xor(ss, 16); ss += __shfl_xor(ss, 32);
                const float r = rsqrtf(ss * (1.f / 64.f) + EPS);
                bf16_t* dst = QK + (size_t)row * 2048 + 1024 + type * 512 + head * 64 + 4 * fq;
#pragma unroll
                for (int n = 0; n < 2; ++n) {
                    const f32x4 c = *(const f32x4*)(cos64 + t * 32 + 16 * n + 4 * fq), s = *(const f32x4*)(sin64 + t * 32 + 16 * n + 4 * fq);
                    const f32x4 y0 = v[0][n] * r * gg[0][n], y1 = v[1][n] * r * gg[1][n];
                    const f32x4 o0 = (y0 * c - y1 * s) * qs, o1 = (y1 * c + y0 * s) * qs;
                    *(u32x2*)(dst + 16 * n) = pk4(o0); *(u32x2*)(dst + 32 + 16 * n) = pk4(o1);
                    cs[0][n] += o0; cs[1][n] += o1;
                }
                asm volatile("" ::: "memory");
            }
        if (type == 1) {
            float* kbar = (float*)(ws + WS_KBAR);
#pragma unroll
            for (int bj = 0; bj < 2; ++bj)
#pragma unroll
                for (int n = 0; n < 2; ++n)
#pragma unroll
                    for (int j = 0; j < 4; ++j) {
                        float x = cs[bj][n][j];
                        x += __shfl_xor(x, 1); x += __shfl_xor(x, 2); x += __shfl_xor(x, 4); x += __shfl_xor(x, 8);
                        if (fr == 0) unsafeAtomicAdd(kbar + ((size_t)u.pm * 8 + head) * 64 + 32 * bj + 16 * n + 4 * fq + j, x);
                    }
        }
    }
};
struct EpiV {
    static constexpr bool PERM = false, AFTER_DRAIN = false;
    unsigned char* ws;
    __device__ __forceinline__ void operator()(const f32x4 (&acc)[2][2][4][2], const pg8::Unit& u, int wr, int wc, int fr, int fq) const {
        const int which = u.pn >> 1, head = (u.pn & 1) * 4 + wc;
        const int rowb = u.pm * 256 + wr * 64 + fr;
        const float* ssq = (const float*)(ws + WS_SSQ);
        const int b = u.pm >> 4, tb = rowb & (SEQL - 1);
        bf16_t* base = (bf16_t*)(ws + WS_VT) + ((size_t)((which * 4 + b) * 8 + head) * 64) * SEQL;
#pragma unroll
        for (int ai = 0; ai < 2; ++ai)
#pragma unroll
            for (int m = 0; m < 4; ++m) {
                const int row = rowb + ai * 128 + m * 16, t = tb + ai * 128 + m * 16;
                const float rs = rsqrtf(ssq[row] * (1.f / DMODEL) + EPS);
#pragma unroll
                for (int bj = 0; bj < 2; ++bj)
#pragma unroll
                    for (int n = 0; n < 2; ++n) {
                        const f32x4 v = acc[ai][bj][m][n] * rs; const int d = 32 * bj + 16 * n + 4 * fq;
                        const u32x2 w = pk4(v);
                        base[(size_t)(d + 0) * SEQL + t] = (bf16_t)(w.x & 0xffffu); base[(size_t)(d + 1) * SEQL + t] = (bf16_t)(w.x >> 16);
                        base[(size_t)(d + 2) * SEQL + t] = (bf16_t)(w.y & 0xffffu); base[(size_t)(d + 3) * SEQL + t] = (bf16_t)(w.y >> 16);
                    }
                asm volatile("" ::: "memory");
            }
    }
};

struct EpiResid {
    static constexpr bool PERM = false, AFTER_DRAIN = false;
    const float* xin; float* xout; bf16_t* xb; float* ssq;
    __device__ __forceinline__ void operator()(const f32x4 (&acc)[2][2][4][2], const pg8::Unit& u, int wr, int wc, int fr, int fq) const {
        const int rowb = u.pm * 256 + wr * 64 + fr, colb = u.pn * 256 + wc * 32 + 4 * fq;
#pragma unroll
        for (int ai = 0; ai < 2; ++ai)
#pragma unroll
            for (int m = 0; m < 4; ++m) {
                const int row = rowb + ai * 128 + m * 16; float ss = 0.f;
#pragma unroll
                for (int bj = 0; bj < 2; ++bj)
#pragma unroll
                    for (int n = 0; n < 2; ++n) {
                        const size_t off = (size_t)row * DMODEL + colb + bj * 128 + n * 16;
                        const f32x4 xn = *(const f32x4*)(xin + off) + acc[ai][bj][m][n];
                        *(f32x4*)(xout + off) = xn;
                        if (xb) *(u32x2*)(xb + off) = pk4(xn);
                        ss += dot4(xn);
                    }
                if (ssq) { ss += __shfl_xor(ss, 16); ss += __shfl_xor(ss, 32); if (fq == 0) unsafeAtomicAdd(ssq + row, ss); }
                asm volatile("" ::: "memory");
            }
    }
};

struct EpiSwiglu {
    static constexpr bool PERM = false, AFTER_DRAIN = false;
    const float* ssq; bf16_t* act;
    __device__ __forceinline__ void operator()(const f32x4 (&acc)[2][2][4][2], const pg8::Unit& u, int wr, int wc, int fr, int fq) const {
        const int rowb = u.pm * 256 + wr * 64 + fr, colb = u.pn * 128 + wc * 32 + 4 * fq;
#pragma unroll
        for (int ai = 0; ai < 2; ++ai)
#pragma unroll
            for (int m = 0; m < 4; ++m) {
                const int row = rowb + ai * 128 + m * 16;
                const float rs = rsqrtf(ssq[row] * (1.f / DMODEL) + EPS);
#pragma unroll
                for (int n = 0; n < 2; ++n) {
                    const f32x4 g = acc[ai][0][m][n] * rs, uu = acc[ai][1][m][n] * rs; f32x4 a;
#pragma unroll
                    for (int j = 0; j < 4; ++j) a[j] = g[j] * fast_sigmoid(g[j]) * uu[j];
                    *(u32x2*)(act + (size_t)row * DFF + colb + n * 16) = pk4(a);
                }
                asm volatile("" ::: "memory");
            }
    }
};

struct EpiOddIn {
    static constexpr bool PERM = false, AFTER_DRAIN = false;
    unsigned char* ws;
    __device__ __forceinline__ void operator()(const f32x4 (&acc)[2][2][4][2], const pg8::Unit& u, int wr, int wc, int fr, int fq) const {
        const int rowb = u.pm * 256 + wr * 64 + fr;
        const float* ssq = (const float*)(ws + WS_SSQ) + 2 * MTOK; const float* bias = (const float*)(ws + WS_PAR) + PB_OBIAS;
        bf16_t* GU = (bf16_t*)(ws + WS_GU); bf16_t* GV = (bf16_t*)(ws + WS_GV); bf16_t* CP = (bf16_t*)(ws + WS_CP); float* gvst = (float*)(ws + WS_GVST);
        if (u.pn < 4) {
            const int colb = u.pn * 256 + wc * 32 + 4 * fq;
            bf16_t* dstb = u.pn < 2 ? GU : GV; const int cadj = u.pn < 2 ? 0 : 512;
#pragma unroll
            for (int ai = 0; ai < 2; ++ai)
#pragma unroll
                for (int m = 0; m < 4; ++m) {
                    const int row = rowb + ai * 128 + m * 16;
                    const float rs = rsqrtf(ssq[row] * (1.f / DMODEL) + EPS); float s1 = 0.f, s2 = 0.f;
#pragma unroll
                    for (int bj = 0; bj < 2; ++bj)
#pragma unroll
                        for (int n = 0; n < 2; ++n) {
                            const int col = colb + bj * 128 + n * 16;
                            const f32x4 x = acc[ai][bj][m][n] * rs + *(const f32x4*)(bias + col); f32x4 y;
#pragma unroll
                            for (int j = 0; j < 4; ++j) { const float z = 1.5957691216057308f * (x[j] + 0.044715f * x[j] * x[j] * x[j]); y[j] = x[j] * fast_sigmoid(z); }
                            *(u32x2*)(dstb + (size_t)row * 512 + col - cadj) = pk4(y);
                            s1 += sum4(y); s2 += dot4(y);
                        }
                    if (u.pn >= 2) {
                        s1 += __shfl_xor(s1, 16); s1 += __shfl_xor(s1, 32); s2 += __shfl_xor(s2, 16); s2 += __shfl_xor(s2, 32);
                        if (fq == 0) { unsafeAtomicAdd(gvst + 2 * row, s1); unsafeAtomicAdd(gvst + 2 * row + 1, s2); }
                    }
                    asm volatile("" ::: "memory");
                }
        } else {
            const int offb = (u.pn - 4) * 128 + wc * 32 + 4 * fq;
#pragma unroll
            for (int ai = 0; ai < 2; ++ai)
#pragma unroll
                for (int m = 0; m < 4; ++m) {
                    const int row = rowb + ai * 128 + m * 16;
                    const float rs = rsqrtf(ssq[row] * (1.f / DMODEL) + EPS);
#pragma unroll
                    for (int n = 0; n < 2; ++n) {
                        const int off = offb + n * 16;
                        const f32x4 a = acc[ai][0][m][n] * rs + *(const f32x4*)(bias + 1024 + off), gt = acc[ai][1][m][n] * rs + *(const f32x4*)(bias + 1536 + off); f32x4 y;
#pragma unroll
                        for (int j = 0; j < 4; ++j) y[j] = a[j] * fast_sigmoid(gt[j]);
                        *(u32x2*)(CP + (size_t)row * 512 + off) = pk4(y);
                    }
                    asm volatile("" ::: "memory");
                }
        }
    }
};

__device__ __forceinline__ int map_row(int mode, int n0) {
    if (mode == 1) { const int seg = n0 >> 9, nseg = seg == 2 ? 4 : (seg == 3 ? 2 : (seg == 4 ? 3 : seg)), l = n0 & 511, pl = l >> 8, l2 = l & 255, wc = l2 >> 6, bj = (l2 >> 5) & 1;
                     return nseg * 512 + pl * 256 + bj * 128 + wc * 32; }
    if (mode == 2) { if (n0 < DFF) return (n0 >> 7) * 256 + (n0 & 127); const int n1 = n0 - DFF; return (n1 >> 7) * 256 + 128 + (n1 & 127); }
    if (mode == 3) { if (n0 < 1024) return n0; if (n0 < 1536) { const int n1 = n0 - 1024; return (4 + (n1 >> 7)) * 256 + (n1 & 127); }
                     const int n1 = n0 - 1536; return (4 + (n1 >> 7)) * 256 + 128 + (n1 & 127); }
    return n0;
}
__device__ __forceinline__ void tr_item(const float* W, int K, int N, bf16_t* WT, int mode, const float* gk, LAS float* scr, int item, int lane) {
    const int nblk = N / 32, kb = item / nblk, nb = item % nblk, k0 = 64 * kb, n0 = 32 * nb;
#pragma unroll 8
    for (int i = 0; i < 32; ++i) { const int kk = 2 * i + (lane >> 5); float w = W[(size_t)(k0 + kk) * N + n0 + (lane & 31)]; if (gk) w *= gk[k0 + kk]; scr[kk * 33 + (lane & 31)] = w; }
    asm volatile("s_waitcnt lgkmcnt(0)" ::: "memory");
    const int c = lane & 7, row0 = map_row(mode, n0);
#pragma unroll
    for (int j = 0; j < 4; ++j) { const int n = (lane >> 3) + 8 * j; const LAS float* s = scr + (8 * c) * 33 + n;
        u32x4 o; o.x = cvtpk(s[0 * 33], s[1 * 33]); o.y = cvtpk(s[2 * 33], s[3 * 33]); o.z = cvtpk(s[4 * 33], s[5 * 33]); o.w = cvtpk(s[6 * 33], s[7 * 33]);
        *(u32x4*)(WT + (size_t)(row0 + n) * K + k0 + 8 * c) = o; }
    asm volatile("s_waitcnt lgkmcnt(0)" ::: "memory");
}

__device__ __forceinline__ void prologue(const Args& a, LAS unsigned char* lds, int vcu, int G, int wid) {
    const int tid = mk_tid(wid), lane = tid & 63;
    unsigned char* ws = a.ws;
    LAS float* scr = (LAS float*)(lds + wid * 16384);
    const int gw = vcu * 8 + wid, NGW = G * 8;
    constexpr int I_EI = 16 * 96, I_EO = 16 * 32, I_FI = 16 * 176, I_FO = 44 * 32, I_OI = 16 * 64, I_OO = 16 * 32;
    constexpr int NITEMS = I_EI + I_EO + 2 * I_FI + 2 * I_FO + I_OI + I_OO;
    for (int it = gw; it < NITEMS; it += NGW) {
        int r = it;
        if (r < I_EI) { tr_item(a.in[5], 1024, 3072, (bf16_t*)(ws + WS_WEI), 1, a.in[1], scr, r, lane); continue; } r -= I_EI;
        if (r < I_EO) { tr_item(a.in[6], 1024, 1024, (bf16_t*)(ws + WS_WEO), 0, nullptr, scr, r, lane); continue; } r -= I_EO;
        if (r < I_FI) { tr_item(a.in[3], 1024, 5632, (bf16_t*)(ws + WS_WFI0), 2, a.in[2], scr, r, lane); continue; } r -= I_FI;
        if (r < I_FI) { tr_item(a.in[3] + (size_t)1024 * 5632, 1024, 5632, (bf16_t*)(ws + WS_WFI1), 2, a.in[2] + 1024, scr, r, lane); continue; } r -= I_FI;
        if (r < I_FO) { tr_item(a.in[4], 2816, 1024, (bf16_t*)(ws + WS_WFO0), 0, nullptr, scr, r, lane); continue; } r -= I_FO;
        if (r < I_FO) { tr_item(a.in[4] + (size_t)2816 * 1024, 2816, 1024, (bf16_t*)(ws + WS_WFO1), 0, nullptr, scr, r, lane); continue; } r -= I_FO;
        if (r < I_OI) { tr_item(a.in[16], 1024, 2048, (bf16_t*)(ws + WS_WOI), 3, a.in[1] + 1024, scr, r, lane); continue; } r -= I_OI;
        tr_item(a.in[18], 1024, 1024, (bf16_t*)(ws + WS_WOO), 0, nullptr, scr, r, lane);
    }
    float* ssq = (float*)(ws + WS_SSQ); bf16_t* XB = (bf16_t*)(ws + WS_XB);
    for (int m = gw; m < MTOK; m += NGW) {
        const f32x4* xr = (const f32x4*)(a.in[0] + (size_t)m * DMODEL) + lane; u32x2* o8 = (u32x2*)(XB + (size_t)m * DMODEL) + lane; float s = 0.f;
#pragma unroll
        for (int j = 0; j < 4; ++j) { const f32x4 v = xr[64 * j]; s += dot4(v); o8[64 * j] = pk4(v); }
        s = wave_sum(s); if (lane == 0) ssq[m] = s;
    }
    const int gt = vcu * 512 + tid, NGT = G * 512;
    for (int i = 16384 + gt; i < 131072; i += NGT) ssq[i] = 0.f;
    for (int i = gt; i < SEQL * 48; i += NGT) {
        const int t = i / 48, e = i % 48; const bool small = e < 16; const int fi = small ? e : e - 16;
        const float inv = 1.0f / powf(10000.0f, small ? (float)fi * (1.f / 16.f) : (float)fi * (1.f / 32.f));
        const float ang = (float)t * inv;
        const double ad = (double)ang, n = rint(ad * 0.15915494309189535), rr = ad - n * 6.283185307179586;
        const float rf = (float)rr, cv = __cosf(rf), sv = __sinf(rf);
        if (small) { ((float*)(ws + WS_COS32))[t * 16 + fi] = cv; ((float*)(ws + WS_SIN32))[t * 16 + fi] = sv; }
        else { ((float*)(ws + WS_COS64))[t * 32 + fi] = cv; ((float*)(ws + WS_SIN64))[t * 32 + fi] = sv; }
    }
    for (int i = gt; i < 8 * 128 * 128; i += NGT) { const int t = (i >> 7) & 127, s = i & 127; ((bf16_t*)(ws + WS_WSB))[i] = s <= t ? f2bf(a.in[21][i]) : (bf16_t)0; }
    if (vcu == 0 && wid == 0) {
        float p1 = 0.f, p2 = 0.f;
        if (lane < 32) { p1 = a.in[9][lane] * a.in[10][lane]; p2 = a.in[11][lane] * a.in[12][lane]; }
        p1 = wave_sum(p1); p2 = wave_sum(p2);
        if (lane == 0) ((float*)(ws + WS_PAR))[PB_LAM] = expf(p1) - expf(p2) + 0.2f;
    }
    {
        float* pb = (float*)(ws + WS_PAR);
        for (int i = gt; i < PB_LAM; i += NGT) {
            float v;
            if (i < PB_KN) v = a.in[7][i - PB_QN]; else if (i < PB_MQN) v = a.in[8][i - PB_KN]; else if (i < PB_MKN) v = a.in[14][i - PB_MQN]; else if (i < PB_SUBLN) v = a.in[15][i - PB_MKN];
            else if (i < PB_OBIAS) v = a.in[13][i - PB_SUBLN]; else if (i < PB_GLNG) v = a.in[17][i - PB_OBIAS]; else if (i < PB_GLNB) v = a.in[19][i - PB_GLNG]; else if (i < PB_GBS) v = a.in[20][i - PB_GLNB];
            else if (i < PB_CW) v = a.in[22][i - PB_GBS]; else if (i < PB_CB) v = a.in[23][i - PB_CW]; else if (i < PB_CLNG) v = a.in[24][i - PB_CB]; else if (i < PB_CLNB) v = a.in[25][i - PB_CLNG]; else v = a.in[26][i - PB_CLNB];
            pb[i] = v;
        }
    }
}

constexpr int KPITCH = 144, VPITCH = 136, KBUF = 64 * KPITCH, VBUF = 64 * VPITCH;
template <bool DIFF>
__device__ __forceinline__ void attn_unit(LAS unsigned char* lds, unsigned char* ws, int b, int hd, int qb, int wid) {
    const float* subln_g = (const float*)(ws + WS_PAR) + PB_SUBLN; bf16_t* MIX = (bf16_t*)(ws + WS_MIX);
    constexpr int NM = DIFF ? 2 : 1;
    const int tid = mk_tid(wid), lane = tid & 63, r = lane & 31, h = lane >> 5;
    const bf16_t* QK = (const bf16_t*)(ws + WS_QK); const bf16_t* VT = (const bf16_t*)(ws + WS_VT);
    const int q0 = qb * 256, qw = q0 + 32 * wid, qrow = qw + r;
    const size_t grow = (size_t)b * SEQL + qrow;
    const bf16_t* Qp = QK + grow * 2048 + (DIFF ? 0 : 1024) + hd * 64;
    const bf16_t* Kg = QK + (size_t)b * SEQL * 2048 + (DIFF ? 512 : 1536) + hd * 64;
    const bf16_t* Vg = VT + ((size_t)(((DIFF ? 0 : 1) * 4 + b) * 8 + hd) * 64) * SEQL;
    bf16x8 qf[4];
#pragma unroll
    for (int i = 0; i < 4; ++i) qf[i] = *(const bf16x8*)(Qp + 16 * i + 8 * h);
    unsigned sel = 0u;
    if (!DIFF) {
        float qv[32];
#pragma unroll
        for (int i = 0; i < 4; ++i) { const u32x4 w = *(const u32x4*)(Qp + 32 * h + 8 * i);
            qv[8 * i + 0] = bflo(w.x); qv[8 * i + 1] = bfhi(w.x); qv[8 * i + 2] = bflo(w.y); qv[8 * i + 3] = bfhi(w.y);
            qv[8 * i + 4] = bflo(w.z); qv[8 * i + 5] = bfhi(w.z); qv[8 * i + 6] = bflo(w.w); qv[8 * i + 7] = bfhi(w.w); }
        float g[15];
        const float* kb0 = (const float*)(ws + WS_KBAR) + ((size_t)(b * 16) * 8 + hd) * 64 + 32 * h;
#pragma unroll
        for (int n = 0; n < 15; ++n) {
            float acc = 0.f;
            if (n < qb) {
                const float* kb = kb0 + (size_t)n * 512;
#pragma unroll
                for (int i = 0; i < 8; ++i) { const f32x4 kv = *(const f32x4*)(kb + 4 * i); acc += qv[4 * i] * kv[0] + qv[4 * i + 1] * kv[1] + qv[4 * i + 2] * kv[2] + qv[4 * i + 3] * kv[3]; }
                acc = hswap_sum(acc);
            }
            g[n] = acc;
        }
#pragma unroll
        for (int pass = 0; pass < 3; ++pass) {
            float best = -INFINITY; int bi = -1;
#pragma unroll
            for (int n = 0; n < 15; ++n) { const bool ok = (n < qb) && !((sel >> n) & 1u) && (g[n] > best); best = ok ? g[n] : best; bi = ok ? n : bi; }
            if (bi >= 0) sel |= 1u << bi;
        }
    }
    f32x16 o[NM][2]; float mrun[NM], lrun[NM];
#pragma unroll
    for (int mp = 0; mp < NM; ++mp) { mrun[mp] = -1e30f; lrun[mp] = 0.f;
#pragma unroll
        for (int d = 0; d < 2; ++d)
#pragma unroll
            for (int i = 0; i < 16; ++i) o[mp][d][i] = 0.f; }
    const int nT = (q0 + 256) / 64;
    const int lrow = tid >> 3, lch = tid & 7;
    const bf16_t* ksrc = Kg + (size_t)lrow * 2048 + lch * 8;
    const bf16_t* vsrc = Vg + (size_t)lrow * SEQL + lch * 8;
    LAS unsigned char* kdst = lds + lrow * KPITCH + lch * 16;
    LAS unsigned char* vdst = lds + 2 * KBUF + lrow * VPITCH + lch * 16;
    u32x4 kreg = *(const u32x4*)ksrc, vreg = *(const u32x4*)vsrc;
    *(LAS u32x4*)kdst = kreg; *(LAS u32x2*)vdst = (u32x2){vreg.x, vreg.y}; *(LAS u32x2*)(vdst + 8) = (u32x2){vreg.z, vreg.w};
    __syncthreads();
    for (int t = 0; t < nT; ++t) {
        const int buf = t & 1, kv0 = t * 64;
        if (t + 1 < nT) { kreg = *(const u32x4*)(ksrc + (size_t)(t + 1) * 64 * 2048); vreg = *(const u32x4*)(vsrc + (t + 1) * 64); }
        bool active = kv0 <= qw + 31;
        const bool past = !DIFF && (t >> 2) < qb;
        const bool use = past ? ((sel >> (t >> 2)) & 1u) != 0u : true;
        if (past) active = active && (__ballot(use) != 0ull);
        if (active) {
            LAS const unsigned char* Kt = lds + buf * KBUF; LAS const unsigned char* Vt = lds + 2 * KBUF + buf * VBUF;
            f32x16 s[NM][2];
#pragma unroll
            for (int kvb = 0; kvb < 2; ++kvb) {
                LAS const unsigned char* kp = Kt + (kvb * 32 + r) * KPITCH + h * 16;
                bf16x8 kf[4];
#pragma unroll
                for (int i = 0; i < 4; ++i) kf[i] = *(LAS const bf16x8*)(kp + 32 * i);
                f32x16 z;
#pragma unroll
                for (int i = 0; i < 16; ++i) z[i] = 0.f;
                if (DIFF) { s[0][kvb] = MFMA32(kf[0], qf[0], z); s[0][kvb] = MFMA32(kf[1], qf[1], s[0][kvb]);
                            s[NM - 1][kvb] = MFMA32(kf[2], qf[2], z); s[NM - 1][kvb] = MFMA32(kf[3], qf[3], s[NM - 1][kvb]); }
                else { s[0][kvb] = MFMA32(kf[0], qf[0], z); s[0][kvb] = MFMA32(kf[1], qf[1], s[0][kvb]); s[0][kvb] = MFMA32(kf[2], qf[2], s[0][kvb]); s[0][kvb] = MFMA32(kf[3], qf[3], s[0][kvb]); }
            }
            if (kv0 + 63 > qw) {
#pragma unroll
                for (int kvb = 0; kvb < 2; ++kvb)
#pragma unroll
                    for (int i = 0; i < 16; ++i) { const bool dead = kv0 + 32 * kvb + crow(i, h) > qrow;
#pragma unroll
                        for (int mp = 0; mp < NM; ++mp) s[mp][kvb][i] = dead ? -INFINITY : s[mp][kvb][i]; }
            }
            if (past) {
#pragma unroll
                for (int kvb = 0; kvb < 2; ++kvb)
#pragma unroll
                    for (int i = 0; i < 16; ++i) s[0][kvb][i] = use ? s[0][kvb][i] : -INFINITY;
            }
#pragma unroll
            for (int mp = 0; mp < NM; ++mp) {
                float tm = fmaxf(s[mp][0][0], s[mp][1][0]);
#pragma unroll
                for (int i = 1; i < 16; ++i) tm = fmaxf(tm, fmaxf(s[mp][0][i], s[mp][1][i]));
                tm = hswap_max(tm);
                const float mn = fmaxf(mrun[mp], tm), alpha = __builtin_amdgcn_exp2f(mrun[mp] - mn);
                mrun[mp] = mn; float rsum = 0.f;
#pragma unroll
                for (int kvb = 0; kvb < 2; ++kvb)
#pragma unroll
                    for (int i = 0; i < 16; ++i) { const float p = __builtin_amdgcn_exp2f(s[mp][kvb][i] - mn); s[mp][kvb][i] = p; rsum += p; }
                lrun[mp] = lrun[mp] * alpha + rsum;
                if (__any(alpha != 1.f)) {
#pragma unroll
                    for (int d = 0; d < 2; ++d)
#pragma unroll
                        for (int i = 0; i < 16; ++i) o[mp][d][i] *= alpha;
                }
            }
#pragma unroll
            for (int kvb = 0; kvb < 2; ++kvb)
#pragma unroll
                for (int ss = 0; ss < 2; ++ss) {
                    bf16x8 pb[NM];
#pragma unroll
                    for (int mp = 0; mp < NM; ++mp) { u32x4 w; w.x = cvtpk(s[mp][kvb][8 * ss + 0], s[mp][kvb][8 * ss + 1]); w.y = cvtpk(s[mp][kvb][8 * ss + 2], s[mp][kvb][8 * ss + 3]);
                        w.z = cvtpk(s[mp][kvb][8 * ss + 4], s[mp][kvb][8 * ss + 5]); w.w = cvtpk(s[mp][kvb][8 * ss + 6], s[mp][kvb][8 * ss + 7]); pb[mp] = __builtin_bit_cast(bf16x8, w); }
#pragma unroll
                    for (int d = 0; d < 2; ++d) {
                        LAS const unsigned char* vp = Vt + (32 * d + r) * VPITCH + (kvb * 32 + 16 * ss + 4 * h) * 2;
                        const s16x4 lo = *(LAS const s16x4*)vp, hi = *(LAS const s16x4*)(vp + 16);
                        const bf16x8 va = __builtin_shufflevector(lo, hi, 0, 1, 2, 3, 4, 5, 6, 7);
#pragma unroll
                        for (int mp = 0; mp < NM; ++mp) o[mp][d] = MFMA32(va, pb[mp], o[mp][d]);
                    }
                }
        }
        if (t + 1 < nT) { LAS unsigned char* kd = kdst + (buf ^ 1) * KBUF; LAS unsigned char* vd = vdst + (buf ^ 1) * VBUF;
            *(LAS u32x4*)kd = kreg; *(LAS u32x2*)vd = (u32x2){vreg.x, vreg.y}; *(LAS u32x2*)(vd + 8) = (u32x2){vreg.z, vreg.w}; }
        __syncthreads();
    }
    float inv[NM];
#pragma unroll
    for (int mp = 0; mp < NM; ++mp) inv[mp] = 1.f / hswap_sum(lrun[mp]);
    if (DIFF) {
        const float lam = ((const float*)(ws + WS_PAR))[PB_LAM]; float ss = 0.f;
#pragma unroll
        for (int d = 0; d < 2; ++d)
#pragma unroll
            for (int i = 0; i < 16; ++i) { const float v = o[0][d][i] * inv[0] - lam * (o[NM - 1][d][i] * inv[NM - 1]); o[0][d][i] = v; ss += v * v; }
        ss = hswap_sum(ss);
        const float rn = rsqrtf(ss * (1.f / 64.f) + EPS) * 0.8f;
#pragma unroll
        for (int d = 0; d < 2; ++d)
#pragma unroll
            for (int g4 = 0; g4 < 4; ++g4) { const int d0 = 32 * d + 8 * g4 + 4 * h; const f32x4 gw = *(const f32x4*)(subln_g + d0);
                f32x4 v; v[0] = o[0][d][4 * g4] * rn * gw[0]; v[1] = o[0][d][4 * g4 + 1] * rn * gw[1]; v[2] = o[0][d][4 * g4 + 2] * rn * gw[2]; v[3] = o[0][d][4 * g4 + 3] * rn * gw[3];
                *(u32x2*)(MIX + grow * DMODEL + hd * 64 + d0) = pk4(v); }
    } else {
#pragma unroll
        for (int d = 0; d < 2; ++d)
#pragma unroll
            for (int g4 = 0; g4 < 4; ++g4) { const int d0 = 32 * d + 8 * g4 + 4 * h;
                f32x4 v; v[0] = o[0][d][4 * g4] * inv[0]; v[1] = o[0][d][4 * g4 + 1] * inv[0]; v[2] = o[0][d][4 * g4 + 2] * inv[0]; v[3] = o[0][d][4 * g4 + 3] * inv[0];
                *(u32x2*)(MIX + grow * DMODEL + 512 + hd * 64 + d0) = pk4(v); }
    }
}

__device__ __forceinline__ void gmlp_item(LAS unsigned char* lds, unsigned char* ws, int item, int wid) {
    const int tid = mk_tid(wid), lane = tid & 63, r = lane & 31, h = lane >> 5;
    const float* pb = (const float*)(ws + WS_PAR);
    const bf16_t* GU = (const bf16_t*)(ws + WS_GU); const bf16_t* GV = (const bf16_t*)(ws + WS_GV); const float* gvst = (const float*)(ws + WS_GVST);
    const bf16_t* WSB = (const bf16_t*)(ws + WS_WSB); bf16_t* MIX = (bf16_t*)(ws + WS_MIX);
    const int ch = item >> 3, g = item & 7; const size_t row0 = (size_t)ch * 128;
    constexpr int GP = 136;
    {
        const int s = tid >> 2, dc = (tid & 3) * 16; const size_t row = row0 + s;
        const bf16_t* src = GV + row * 512 + g * 64 + dc; const u32x4 w0 = *(const u32x4*)src, w1 = *(const u32x4*)(src + 8);
        const float s1 = gvst[2 * row], s2 = gvst[2 * row + 1], mean = s1 * (1.f / 512.f), var = fmaxf(s2 * (1.f / 512.f) - mean * mean, 0.f), rstd = rsqrtf(var + EPS);
        const float* lg = pb + PB_GLNG + g * 64 + dc; const float* lb = pb + PB_GLNB + g * 64 + dc;
        LAS bf16_t* dst = (LAS bf16_t*)lds + dc * GP + s;
        const unsigned ww[8] = {w0.x, w0.y, w0.z, w0.w, w1.x, w1.y, w1.z, w1.w};
#pragma unroll
        for (int i = 0; i < 8; ++i) {
            const float y0 = (bflo(ww[i]) - mean) * rstd * lg[2 * i] + lb[2 * i], y1 = (bfhi(ww[i]) - mean) * rstd * lg[2 * i + 1] + lb[2 * i + 1];
            dst[(2 * i) * GP] = f2bf(y0); dst[(2 * i + 1) * GP] = f2bf(y1);
        }
    }
    __syncthreads();
    const int mb = wid & 3, nb = wid >> 2;
    f32x16 acc;
#pragma unroll
    for (int i = 0; i < 16; ++i) acc[i] = 0.f;
    const bf16_t* Ap = WSB + ((size_t)g * 128 + 32 * mb + r) * 128 + 8 * h;
    LAS const unsigned char* Bp = lds + ((32 * nb + r) * GP + 8 * h) * 2;
#pragma unroll
    for (int kk = 0; kk < 8; ++kk)
        if (kk < 2 * (mb + 1)) { const bf16x8 av = *(const bf16x8*)(Ap + 16 * kk); const bf16x8 bv = *(LAS const bf16x8*)(Bp + 32 * kk); acc = MFMA32(av, bv, acc); }
    const int c = g * 64 + 32 * nb + r;
#pragma unroll
    for (int i = 0; i < 16; ++i) { const int t = 32 * mb + crow(i, h); const size_t row = row0 + t;
        const float sg = acc[i] + pb[PB_GBS + g * 128 + t]; MIX[row * DMODEL + c] = f2bf(bf2f(GU[row * 512 + c]) * sg); }
    __syncthreads();
}
__device__ __forceinline__ void conv_item(LAS unsigned char* lds, unsigned char* ws, int item, int wid) {
    const float* pb = (const float*)(ws + WS_PAR);
    const int tid = mk_tid(wid), lane = tid & 63;
    const bf16_t* CP = (const bf16_t*)(ws + WS_CP); bf16_t* MIX = (bf16_t*)(ws + WS_MIX);
    const size_t row0 = (size_t)item * 32; const int pos0 = (int)(row0 & (SEQL - 1)); const int c = tid;
    float in[62];
#pragma unroll
    for (int i = 0; i < 62; ++i) { const int p = pos0 + i - 30; in[i] = p >= 0 ? bf2f(CP[(row0 + i - 30) * 512 + c]) : 0.f; }
    float w[31];
#pragma unroll
    for (int k = 0; k < 31; ++k) w[k] = pb[PB_CW + k * 512 + c];
    const float bb = pb[PB_CB + c];
    LAS float* outl = (LAS float*)lds;
#pragma unroll
    for (int t = 0; t < 32; ++t) { float acc = bb;
#pragma unroll
        for (int k = 0; k < 31; ++k) acc += w[k] * in[t + k];
        outl[t * 512 + c] = acc; }
    __syncthreads();
    const f32x4 g0 = *(const f32x4*)(pb + PB_CLNG + lane * 8), g1 = *(const f32x4*)(pb + PB_CLNG + lane * 8 + 4), b0 = *(const f32x4*)(pb + PB_CLNB + lane * 8), b1 = *(const f32x4*)(pb + PB_CLNB + lane * 8 + 4);
#pragma unroll
    for (int tt = 0; tt < 4; ++tt) {
        const int t = 4 * wid + tt;
        const f32x4 v0 = *(LAS const f32x4*)(outl + t * 512 + lane * 8), v1 = *(LAS const f32x4*)(outl + t * 512 + lane * 8 + 4);
        const float s1 = wave_sum(sum4(v0) + sum4(v1)), mean = s1 * (1.f / 512.f);
        const f32x4 d0 = v0 - mean, d1 = v1 - mean;
        const float s2 = wave_sum(dot4(d0) + dot4(d1)), rstd = rsqrtf(s2 * (1.f / 512.f) + EPS);
        f32x4 y0 = d0 * rstd * g0 + b0, y1 = d1 * rstd * g1 + b1;
#pragma unroll
        for (int j = 0; j < 4; ++j) { y0[j] = y0[j] * fast_sigmoid(y0[j]); y1[j] = y1[j] * fast_sigmoid(y1[j]); }
        u32x4 o; o.x = cvtpk(y0[0], y0[1]); o.y = cvtpk(y0[2], y0[3]); o.z = cvtpk(y1[0], y1[1]); o.w = cvtpk(y1[2], y1[3]);
        *(u32x4*)(MIX + (row0 + t) * DMODEL + 512 + lane * 8) = o;
    }
    __syncthreads();
}

#define WSP(var) unsigned char* var = a.ws; asm volatile("" : "+s"(var))
template <int LAYER> __device__ __forceinline__ void tail_phases(const Args& a, LAS unsigned char* lds, cg::grid_group& grid, int G, int bx, int wid) {
    {
        WSP(ws);
        pg8::Gemm g{(const bf16_t*)(ws + WS_MIX), (const bf16_t*)(ws + (LAYER == 0 ? WS_WEO : WS_WOO)), MTOK, 1024, 1024}; pg8::StaticOrder S; S.init(MTOK, 1024, G, bx);
        EpiResid E{LAYER == 0 ? a.in[0] : a.out, a.out, (bf16_t*)(ws + WS_XB), (float*)(ws + WS_SSQ) + (LAYER == 0 ? 1 : 3) * MTOK};
#ifndef NO_GR
        pg8::gemm_phase<EpiResid, pg8::StaticOrder, true, true>(lds, g, S, E, wid);
#endif
    }
    grid.sync();
    {
        WSP(ws);
        pg8::Gemm g{(const bf16_t*)(ws + WS_XB), (const bf16_t*)(ws + (LAYER == 0 ? WS_WFI0 : WS_WFI1)), MTOK, 2 * DFF, 1024}; pg8::StaticOrder S; S.init(MTOK, 2 * DFF, G, bx);
        EpiSwiglu E{(const float*)(ws + WS_SSQ) + (LAYER == 0 ? 1 : 3) * MTOK, (bf16_t*)(ws + WS_ACT)};
#ifndef NO_GS
        pg8::gemm_phase<EpiSwiglu, pg8::StaticOrder, true, true>(lds, g, S, E, wid);
#endif
    }
    grid.sync();
    {
        WSP(ws);
        pg8::Gemm g{(const bf16_t*)(ws + WS_ACT), (const bf16_t*)(ws + (LAYER == 0 ? WS_WFO0 : WS_WFO1)), MTOK, 1024, DFF}; pg8::StaticOrder S; S.init(MTOK, 1024, G, bx);
        EpiResid E{a.out, a.out, LAYER == 0 ? (bf16_t*)(ws + WS_XB) : nullptr, LAYER == 0 ? (float*)(ws + WS_SSQ) + 2 * MTOK : nullptr};
#ifndef NO_GR
        pg8::gemm_phase<EpiResid, pg8::StaticOrder, true, true>(lds, g, S, E, wid);
#endif
    }
}

__global__ void __launch_bounds__(512, 2) mega_fwd(Args a) {
    extern __shared__ __attribute__((aligned(16))) unsigned char smem[];
    cg::grid_group grid = cg::this_grid();
    LAS unsigned char* lds = (LAS unsigned char*)smem;
    const int G = gridDim.x, bx = blockIdx.x, wid = __builtin_amdgcn_readfirstlane(threadIdx.x >> 6);
#define VCU ((G % 8 == 0) ? (bx % 8) * (G / 8) + bx / 8 : bx)
#ifndef NO_PRO
    prologue(a, lds, VCU, G, wid);
#endif
    grid.sync();
    {
        WSP(ws);
        pg8::Gemm g{(const bf16_t*)(ws + WS_XB), (const bf16_t*)(ws + WS_WEI), MTOK, 1024, 1024}; pg8::StaticOrder S; S.init(MTOK, 1024, G, bx); EpiDiffQK E{ws};
#ifndef NO_GEI
        pg8::gemm_phase<EpiDiffQK, pg8::StaticOrder, true, true>(lds, g, S, E, wid);
#endif
    }
    {
        WSP(ws);
        pg8::Gemm g{(const bf16_t*)(ws + WS_XB), (const bf16_t*)(ws + WS_WEI) + (size_t)1024 * 1024, MTOK, 1024, 1024}; pg8::StaticOrder S; S.init(MTOK, 1024, G, bx); EpiMobaQK E{ws};
#ifndef NO_GEI
        pg8::gemm_phase<EpiMobaQK, pg8::StaticOrder, true, true>(lds, g, S, E, wid);
#endif
    }
    {
        WSP(ws);
        pg8::Gemm g{(const bf16_t*)(ws + WS_XB), (const bf16_t*)(ws + WS_WEI) + (size_t)2048 * 1024, MTOK, 1024, 1024}; pg8::StaticOrder S; S.init(MTOK, 1024, G, bx); EpiV E{ws};
#ifndef NO_GEI
        pg8::gemm_phase<EpiV, pg8::StaticOrder, true, true>(lds, g, S, E, wid);
#endif
    }
    grid.sync();
    {
        WSP(ws);
        for (int u = VCU; u < 256; u += G) {
            const int bh = u >> 3, s = u & 7, b = bh >> 3, hd = bh & 7;
#ifndef NO_AD
            attn_unit<true>(lds, ws, b, hd, 15 - s, wid);
            attn_unit<true>(lds, ws, b, hd, s, wid);
#endif
#ifndef NO_AM
            attn_unit<false>(lds, ws, b, hd, 15 - s, wid);
            attn_unit<false>(lds, ws, b, hd, s, wid);
#endif
        }
    }
    grid.sync();
    tail_phases<0>(a, lds, grid, G, bx, wid);
    grid.sync();
    {
        WSP(ws);
        pg8::Gemm g{(const bf16_t*)(ws + WS_XB), (const bf16_t*)(ws + WS_WOI), MTOK, 2048, 1024}; pg8::StaticOrder S; S.init(MTOK, 2048, G, bx); EpiOddIn E{ws};
#ifndef NO_GOI
        pg8::gemm_phase<EpiOddIn, pg8::StaticOrder, true, true>(lds, g, S, E, wid);
#endif
    }
    grid.sync();
    {
        WSP(ws);
        for (int it = bx; it < 1024 + 512; it += G) {
#ifndef NO_GM
            if (it < 1024) gmlp_item(lds, ws, it, wid);
#endif
#ifndef NO_CV
            if (it >= 1024) conv_item(lds, ws, it - 1024, wid);
#endif
        }
    }
    grid.sync();
    tail_phases<1>(a, lds, grid, G, bx, wid);
}

extern "C" void kernel_launch(void* const* d_in, const int* in_sizes, int n_in, void* d_out, int out_size, void* d_ws, size_t ws_size, hipStream_t stream) {
    static int grid = 0;
    if (grid == 0) {
        if (n_in != 27 || out_size != MTOK * DMODEL || ws_size < WS_END) { fprintf(stderr, "kernel_launch: unexpected shapes (n_in %d out %d ws %zu)\n", n_in, out_size, ws_size); grid = -1; return; }
        int dev = 0, cus = 0, per_cu = 0;
        hipGetDevice(&dev); hipDeviceGetAttribute(&cus, hipDeviceAttributeMultiprocessorCount, dev);
        hipFuncSetAttribute((const void*)mega_fwd, hipFuncAttributeMaxDynamicSharedMemorySize, LDS_BYTES);
        hipOccupancyMaxActiveBlocksPerMultiprocessor(&per_cu, (const void*)mega_fwd, 512, LDS_BYTES);
        if (per_cu < 1) { fprintf(stderr, "kernel_launch: occupancy query says %d blocks/CU\n", per_cu); per_cu = 1; }
        (void)hipGetLastError();
        grid = cus;
    }
    if (grid < 0) return;
    Args a{};
    for (int i = 0; i < 27; ++i) a.in[i] = (const float*)d_in[i];
    a.out = (float*)d_out; a.ws = (unsigned char*)d_ws;
    void* args[] = {&a};
    hipError_t e = hipLaunchCooperativeKernel((const void*)mega_fwd, dim3(grid), dim3(512), args, LDS_BYTES, stream);
    if (e != hipSuccess) fprintf(stderr, "cooperative launch failed: %s (grid %d)\n", hipGetErrorString(e), grid);
}
```

```cpp
#include <hip/hip_runtime.h>
#include <hip/hip_cooperative_groups.h>
#include <hip/hip_bf16.h>
#include <cstdio>
#include <cstdint>
namespace cg = cooperative_groups;
namespace pg8 {
#define PG8_LAS __attribute__((address_space(3)))
typedef unsigned short bf16_t;
typedef short bf16x8 __attribute__((ext_vector_type(8)));
typedef float f32x4 __attribute__((ext_vector_type(4)));
typedef unsigned u32x4 __attribute__((ext_vector_type(4)));
constexpr int BM = 256, BK = 64, HALF = 128, HTB = HALF * BK * 2  , STAGE_BYTES = 8 * HTB, NXCD = 8, WGM = 8;

__host__ __device__ __forceinline__ int lds_byte(int r, int c) { const int st = (r >> 4) * 2 + (c >> 5), rr = r & 15, cc = c & 31, ob = rr * 64 + cc * 2; return st * 1024 + (ob ^ (((ob >> 9) & 1) << 5)); }
__host__ __device__ __forceinline__ void stage_rc(int b, int& R, int& C) { const int st = b / 1024, sb = b % 1024, swz = sb ^ (((sb >> 9) & 1) << 5); R = (st >> 1) * 16 + swz / 64; C = (st & 1) * 32 + (swz % 64) / 2; }
__host__ __device__ __forceinline__ int perm32(int rho) { const int n = rho >> 4, i = rho & 15; return 8 * (i >> 2) + 4 * n + (i & 3); }

struct Unit { int pm, pn; };
struct Gemm { const bf16_t* A; const bf16_t* Bt; int M, N, K; };

struct StaticOrder {
    int nM, nN, nwg, G, c;
    __host__ __device__ void init(int M, int N, int G_, int c_) { nM = M / BM; nN = N / BM; nwg = nM * nN; G = G_; c = c_; }
    __host__ __device__ bool next(int i, Unit& u) const {
        const long L = (long)i * G + c; if (L >= nwg) return false;
        int wgid = (int)L; { const int q = nwg / NXCD, r = nwg % NXCD, xcd = wgid % NXCD, off = wgid / NXCD; wgid = (xcd < r ? xcd * (q + 1) : r * (q + 1) + (xcd - r) * q) + off; }
        const int nig = WGM * nN, gid = wgid / nig, fm = gid * WGM, gsz = (nM - fm) < WGM ? (nM - fm) : WGM;
        u.pm = fm + ((wgid % nig) % gsz); u.pn = (wgid % nig) / gsz; return true;
    }
    __device__ __forceinline__ void a_ready(const Unit&) const {}
    __device__ __forceinline__ void done(const Unit&) const {}
};

__device__ __forceinline__ unsigned cvt_pk_bf16(float lo, float hi) { unsigned r; asm volatile("v_cvt_pk_bf16_f32 %0, %1, %2" : "=v"(r) : "v"(lo), "v"(hi)); return r; }
typedef float f32x2 __attribute__((ext_vector_type(2)));
__device__ __forceinline__ f32x2 gelu_pk(f32x2 v) {
    const f32x2 av = __builtin_elementwise_abs(v), d = av * 0.2316418882f + 1.0f;
    f32x2 t; t.x = __builtin_amdgcn_rcpf(d.x); t.y = __builtin_amdgcn_rcpf(d.y);
    f32x2 q = t * 0.5307027145f + (-0.7265760135f); q = q * t + 0.7107068705f; q = q * t + (-0.142248368f); q = q * t + 0.127414796f; q = q * t;
    const f32x2 s = (v * v) * (-0.72134752044f);
    f32x2 e; e.x = __builtin_amdgcn_exp2f(s.x); e.y = __builtin_amdgcn_exp2f(s.y);
    const f32x2 m = v * (q * e), r = v - m;
    f32x2 o; o.x = v.x < 0.f ? m.x : r.x; o.y = v.y < 0.f ? m.y : r.y; return o;
}

template <int ACT  > struct EpiBf16 {
    static constexpr bool PERM = true, AFTER_DRAIN = false; static_assert(ACT == 0 || ACT == 1, "EpiBf16: ACT is 0 (none) or 1 (gelu_pk)");
    bf16_t* O; int ldc; const float* bias; int split_cols; size_t split_stride; float scale0;
    __device__ __forceinline__ void operator()(const f32x4 (&acc)[2][2][4][2], const Unit& u, int wr, int wc, int fr, int fq) const {
        const int row0 = u.pm * BM + wr * 64 + fr; int colt = u.pn * BM; bf16_t* base = O;
        float sc = 1.f; if (split_cols) { const int t = colt / split_cols; base += (size_t)t * split_stride; colt -= t * split_cols; if (t == 0) sc = scale0; }
        const int col0 = colt + wc * 32 + 8 * fq, bcol0 = u.pn * BM + wc * 32 + 8 * fq;
        f32x4 bv[2][2];
#pragma unroll
        for (int bj = 0; bj < 2; ++bj)
#pragma unroll
            for (int n = 0; n < 2; ++n) bv[bj][n] = bias ? *(const f32x4*)(bias + bcol0 + bj * HALF + 4 * n) : (f32x4){0.f, 0.f, 0.f, 0.f};
#pragma unroll
        for (int ai = 0; ai < 2; ++ai)
#pragma unroll
            for (int m = 0; m < 4; ++m) { bf16_t* rowp = base + (size_t)(row0 + ai * HALF + m * 16) * ldc + col0;
#pragma unroll
                for (int bj = 0; bj < 2; ++bj) { f32x4 v0 = acc[ai][bj][m][0] + bv[bj][0], v1 = acc[ai][bj][m][1] + bv[bj][1];
                    if (ACT == 1) { f32x2 a = gelu_pk((f32x2){v0[0], v0[1]}), b = gelu_pk((f32x2){v0[2], v0[3]}), c = gelu_pk((f32x2){v1[0], v1[1]}), d = gelu_pk((f32x2){v1[2], v1[3]});
                        v0 = (f32x4){a.x, a.y, b.x, b.y}; v1 = (f32x4){c.x, c.y, d.x, d.y}; }
                    v0 = v0 * sc; v1 = v1 * sc; u32x4 w; w.x = cvt_pk_bf16(v0[0], v0[1]); w.y = cvt_pk_bf16(v0[2], v0[3]); w.z = cvt_pk_bf16(v1[0], v1[1]); w.w = cvt_pk_bf16(v1[2], v1[3]);
                    *(u32x4*)(rowp + bj * HALF) = w; } }
    }
};

struct PanelStats {
    unsigned* xbuf;
    unsigned* cnt;
    unsigned* tmo;
    int ntn; float eps;
    unsigned code;
    __device__ __forceinline__ bool run(const f32x4 (&v)[2][2][4][2], const Unit& u, int wr, int wc, int fr, int fq, PG8_LAS unsigned char* lds, int wid, int lane) const {
        typedef float f32x2v __attribute__((ext_vector_type(2)));
        PG8_LAS f32x2v* P = (PG8_LAS f32x2v*)lds;
        PG8_LAS f32x2v* S = (PG8_LAS f32x2v*)(lds + 8192);
        PG8_LAS unsigned* flag = (PG8_LAS unsigned*)(lds + 8192 + 2048);
#pragma unroll
        for (int ai = 0; ai < 2; ++ai)
#pragma unroll
            for (int m = 0; m < 4; ++m) {
                float s = 0.f;
#pragma unroll
                for (int bj = 0; bj < 2; ++bj)
#pragma unroll
                    for (int n = 0; n < 2; ++n) { const f32x4 x = v[ai][bj][m][n]; s += (x[0] + x[1]) + (x[2] + x[3]); }
                s += __shfl_xor(s, 16); s += __shfl_xor(s, 32);
                const float mw = s * (1.0f / 64.0f); float q = 0.f;
#pragma unroll
                for (int bj = 0; bj < 2; ++bj)
#pragma unroll
                    for (int n = 0; n < 2; ++n) { const f32x4 d = v[ai][bj][m][n] - mw; q += (d[0] * d[0] + d[1] * d[1]) + (d[2] * d[2] + d[3] * d[3]); }
                q += __shfl_xor(q, 16); q += __shfl_xor(q, 32);
                if (fq == 0) P[(ai * HALF + wr * 64 + m * 16 + fr) * 4 + wc] = (f32x2v){mw, q};
            }
        asm volatile("s_waitcnt lgkmcnt(0)" ::: "memory"); __builtin_amdgcn_s_barrier(); asm volatile("" ::: "memory");
#if defined(BROKEN_EXCHANGE_NO_WAIT)
#warning BROKEN CONTROL BUILD: the row-statistics exchange does not wait; results are wrong by design
        if (blockIdx.x >= 64) { const long long t0_ = clock64(); while (clock64() - t0_ < 60000) __builtin_amdgcn_s_sleep(8); }
#endif
        const int row = wid * 32 + (lane & 31);
        if (lane < 32) {
            const f32x2v a = P[row * 4 + 0], b = P[row * 4 + 1], c = P[row * 4 + 2], d = P[row * 4 + 3];
            const float mt = (a.x + b.x + c.x + d.x) * 0.25f;
            const float da = a.x - mt, db = b.x - mt, dc = c.x - mt, dd = d.x - mt;
            const float m2 = (a.y + b.y) + (c.y + d.y) + 64.0f * ((da * da + db * db) + (dc * dc + dd * dd));
            unsigned long long* slot = (unsigned long long*)xbuf + ((size_t)(u.pm * BM + row) * 4 + u.pn);
            __hip_atomic_store(slot, ((unsigned long long)__float_as_uint(m2) << 32) | __float_as_uint(mt), __ATOMIC_RELAXED, __HIP_MEMORY_SCOPE_AGENT);
        }
        asm volatile("s_waitcnt vmcnt(0)" ::: "memory");
        if (lane == 0) __hip_atomic_fetch_add(cnt + 64 * u.pm, 1u, __ATOMIC_RELAXED, __HIP_MEMORY_SCOPE_AGENT);
        if (wid == 0) {
            bool dead = false; const unsigned long long t0 = __builtin_amdgcn_s_memrealtime(); const unsigned want = 8u * (unsigned)ntn;
            for (;;) {
#if defined(BROKEN_EXCHANGE_NO_WAIT)
                break;
#endif
                if ((unsigned)__builtin_amdgcn_readfirstlane(__hip_atomic_load(cnt + 64 * u.pm, __ATOMIC_RELAXED, __HIP_MEMORY_SCOPE_AGENT)) >= want) break;
                if (__builtin_amdgcn_s_memrealtime() - t0 > 2000000ull) {
                    if (lane == 0) { unsigned expect = 0u; __hip_atomic_compare_exchange_strong(tmo + 1, &expect, code | (unsigned)(u.pm & 0xff), __ATOMIC_RELAXED, __ATOMIC_RELAXED, __HIP_MEMORY_SCOPE_AGENT);
                                     __hip_atomic_store(tmo, 1u, __ATOMIC_RELAXED, __HIP_MEMORY_SCOPE_AGENT); }
                    dead = true; break; }
                __builtin_amdgcn_s_sleep(2);
            }
            __builtin_amdgcn_fence(__ATOMIC_ACQUIRE, "agent");
            if (lane == 0) flag[0] = dead ? 1u : 0u;
        }
        asm volatile("s_waitcnt vmcnt(0) lgkmcnt(0)" ::: "memory"); __builtin_amdgcn_s_barrier(); asm volatile("" ::: "memory");
        const bool bad = flag[0] != 0u;
        if (lane < 32) {
            const unsigned long long* slot = (const unsigned long long*)xbuf + (size_t)(u.pm * BM + row) * 4; float mt[4], m2[4]; float ms = 0.f;
#pragma unroll
            for (int t = 0; t < 4; ++t) { if (t < ntn) { const unsigned long long w = __hip_atomic_load(slot + t, __ATOMIC_RELAXED, __HIP_MEMORY_SCOPE_AGENT); mt[t] = __uint_as_float((unsigned)w); m2[t] = __uint_as_float((unsigned)(w >> 32)); } else { mt[t] = 0.f; m2[t] = 0.f; } ms += mt[t]; }
            const float mean = ms / (float)ntn; float q = 0.f;
#pragma unroll
            for (int t = 0; t < 4; ++t) if (t < ntn) { const float dm = mt[t] - mean; q += m2[t] + 256.0f * dm * dm; }
            S[row] = (f32x2v){mean, 1.0f / sqrtf(q / (256.0f * (float)ntn) + eps)};
        }
        asm volatile("s_waitcnt lgkmcnt(0)" ::: "memory"); __builtin_amdgcn_s_barrier(); asm volatile("" ::: "memory");
        return bad;
    }
};
struct EpiLnRes {
    static constexpr bool PERM = false, AFTER_DRAIN = true;
    const float* base; float* out; int ldc; const float* bias; PanelStats st; unsigned poison;
    __device__ __forceinline__ void fused(f32x4 (&acc)[2][2][4][2], const Unit& u, int wr, int wc, int fr, int fq, PG8_LAS unsigned char* lds, int wid, int lane) const {
        typedef float f32x2v __attribute__((ext_vector_type(2)));
        const PG8_LAS f32x2v* S = (const PG8_LAS f32x2v*)(lds + 8192);
        const int col0 = u.pn * BM + wc * 32 + 4 * fq;
#pragma unroll
        for (int bj = 0; bj < 2; ++bj)
#pragma unroll
            for (int n = 0; n < 2; ++n) { const f32x4 bv = bias ? *(const f32x4*)(bias + col0 + bj * HALF + n * 16) : (f32x4){0.f, 0.f, 0.f, 0.f};
#pragma unroll
                for (int ai = 0; ai < 2; ++ai)
#pragma unroll
                    for (int m = 0; m < 4; ++m) acc[ai][bj][m][n] += bv; }
        f32x4 pre[4][2][2];
#pragma unroll
        for (int m = 0; m < 4; ++m) { const size_t off = (size_t)(u.pm * BM + wr * 64 + m * 16 + fr) * ldc + col0;
#pragma unroll
            for (int bj = 0; bj < 2; ++bj)
#pragma unroll
                for (int n = 0; n < 2; ++n) pre[m][bj][n] = *(const f32x4*)(base + off + bj * HALF + n * 16); }
        const bool bad = st.run(acc, u, wr, wc, fr, fq, lds, wid, lane) || poison != 0u;
        const float qnan = __builtin_nanf("");
#pragma unroll
        for (int ai = 0; ai < 2; ++ai)
#pragma unroll
            for (int m = 0; m < 4; ++m) { const int r = ai * HALF + wr * 64 + m * 16 + fr; const f32x2v sr = S[r]; const size_t off = (size_t)(u.pm * BM + r) * ldc + col0;
#pragma unroll
                for (int bj = 0; bj < 2; ++bj)
#pragma unroll
                    for (int n = 0; n < 2; ++n) { const f32x4 bs = ai == 0 ? pre[m][bj][n] : *(const f32x4*)(base + off + bj * HALF + n * 16); f32x4 o = bs + (acc[ai][bj][m][n] - sr.x) * sr.y;
                        if (bad) o = (f32x4){qnan, qnan, qnan, qnan}; *(f32x4*)(out + off + bj * HALF + n * 16) = o; }
                if (m & 1) asm volatile("" ::: "memory"); }
    }
};
struct EpiLnResLn {
    static constexpr bool PERM = false, AFTER_DRAIN = true;
    const float* base; float* out; bf16_t* xn; int ldc; const float* bias; PanelStats st1, st2; unsigned poison;
    __device__ __forceinline__ void fused(f32x4 (&acc)[2][2][4][2], const Unit& u, int wr, int wc, int fr, int fq, PG8_LAS unsigned char* lds, int wid, int lane) const {
        typedef float f32x2v __attribute__((ext_vector_type(2))); typedef unsigned u32x2v __attribute__((ext_vector_type(2)));
        const PG8_LAS f32x2v* S = (const PG8_LAS f32x2v*)(lds + 8192);
        const int col0 = u.pn * BM + wc * 32 + 4 * fq;
#pragma unroll
        for (int bj = 0; bj < 2; ++bj)
#pragma unroll
            for (int n = 0; n < 2; ++n) { const f32x4 bv = bias ? *(const f32x4*)(bias + col0 + bj * HALF + n * 16) : (f32x4){0.f, 0.f, 0.f, 0.f};
#pragma unroll
                for (int ai = 0; ai < 2; ++ai)
#pragma unroll
                    for (int m = 0; m < 4; ++m) acc[ai][bj][m][n] += bv; }
        bool bad = st1.run(acc, u, wr, wc, fr, fq, lds, wid, lane) || poison != 0u;
        const float qnan = __builtin_nanf("");
#pragma unroll
        for (int ai = 0; ai < 2; ++ai)
#pragma unroll
            for (int m = 0; m < 4; ++m) { const int r = ai * HALF + wr * 64 + m * 16 + fr; const f32x2v sr = S[r]; const size_t off = (size_t)(u.pm * BM + r) * ldc + col0;
#pragma unroll
                for (int bj = 0; bj < 2; ++bj)
#pragma unroll
                    for (int n = 0; n < 2; ++n) { const f32x4 bs = *(const f32x4*)(base + off + bj * HALF + n * 16); acc[ai][bj][m][n] = bs + (acc[ai][bj][m][n] - sr.x) * sr.y; }
                asm volatile("" : "+v"(acc[ai][0][m][0]), "+v"(acc[ai][0][m][1]), "+v"(acc[ai][1][m][0]), "+v"(acc[ai][1][m][1]));
                if (m & 1) asm volatile("" ::: "memory"); }
        const bool bad1 = bad;
        bad = st2.run(acc, u, wr, wc, fr, fq, lds, wid, lane) || bad;
#pragma unroll
        for (int ai = 0; ai < 2; ++ai)
#pragma unroll
            for (int m = 0; m < 4; ++m) { const int r = ai * HALF + wr * 64 + m * 16 + fr; const f32x2v sr = S[r]; const size_t off = (size_t)(u.pm * BM + r) * ldc + col0;
#pragma unroll
                for (int bj = 0; bj < 2; ++bj)
#pragma unroll
                    for (int n = 0; n < 2; ++n) { const f32x4 x1 = acc[ai][bj][m][n]; *(f32x4*)(out + off + bj * HALF + n * 16) = bad1 ? (f32x4){qnan, qnan, qnan, qnan} : x1;
                        const f32x4 o = (x1 - sr.x) * sr.y; u32x2v w; w.x = cvt_pk_bf16(o[0], o[1]); w.y = cvt_pk_bf16(o[2], o[3]);
                        if (bad) { w.x = 0x7fc07fc0u; w.y = 0x7fc07fc0u; } *(u32x2v*)(xn + off + bj * HALF + n * 16) = w; }
                asm volatile("" ::: "memory"); }
    }
};

template <class Epi, class Sched, bool ALIGN_EPI = false, bool SP2 = false>
__device__ __forceinline__ void gemm_phase(PG8_LAS unsigned char* lds, const Gemm g, const Sched& S, const Epi& E, int wid_s) {
    int lane_; asm volatile("v_mbcnt_lo_u32_b32 %0, -1, 0\n\tv_mbcnt_hi_u32_b32 %0, -1, %0" : "=v"(lane_));
    const int tid = wid_s * 64 + lane_, wid = wid_s, lane = tid & 63, wr = wid >> 2, wc = wid & 3, fr = lane & 15, fq = lane >> 4;
    const int K = g.K, nt = K / BK;
    unsigned voffA[2], voffB[2];
#pragma unroll
    for (int i = 0; i < 2; ++i) { int R, C; stage_rc(tid * 16 + i * 8192, R, C); const int Rb = Epi::PERM ? ((R & ~31) + perm32(R & 31)) : R;
        voffA[i] = (unsigned)(R * K + C) * 2u; voffB[i] = (unsigned)(Rb * K + C) * 2u; }
    const size_t kstep = (size_t)(BK * 2);
    const size_t hstep = (size_t)HALF * K * 2;
    const size_t tstep = 2 * hstep;
    const unsigned ldsw = (unsigned)wid * 1024u;
    const int aoff = lds_byte(wr * 64 + fr, fq * 8), boff = lds_byte(wc * 32 + fr, fq * 8);
#define PG8_SA(b, h) (((b) * 2 + (h)) * HTB)
#define PG8_SB(b, h) ((4 + (b) * 2 + (h)) * HTB)
#define PG8_STAGE(bufoff, gbase, voff) do { _Pragma("unroll") for (int _i = 0; _i < 2; ++_i) \
        __builtin_amdgcn_global_load_lds((const unsigned*)((const char*)(gbase) + (voff)[_i]), (PG8_LAS unsigned*)(lds + (bufoff) + ldsw + _i * 8192), 16, 0, 0); } while (0)
#define PG8_LDA(dst, b, h) do { _Pragma("unroll") for (int m = 0; m < 4; ++m) _Pragma("unroll") for (int k = 0; k < 2; ++k) dst[m][k] = *(const PG8_LAS bf16x8*)(lds + PG8_SA(b, h) + aoff + m * 2048 + k * 1024); } while (0)
#define PG8_LDB(dst, b, h) do { _Pragma("unroll") for (int n = 0; n < 2; ++n) _Pragma("unroll") for (int k = 0; k < 2; ++k) dst[n][k] = *(const PG8_LAS bf16x8*)(lds + PG8_SB(b, h) + boff + n * 2048 + k * 1024); } while (0)
#define PG8_MMA(ai, bj, At, Bt) do { __builtin_amdgcn_s_setprio(1); _Pragma("unroll") for (int m = 0; m < 4; ++m) _Pragma("unroll") for (int n = 0; n < 2; ++n) _Pragma("unroll") for (int k = 0; k < 2; ++k) \
        acc[ai][bj][m][n] = __builtin_amdgcn_mfma_f32_16x16x32_bf16(Bt[n][k], At[m][k], acc[ai][bj][m][n], 0, 0, 0); __builtin_amdgcn_s_setprio(0); } while (0)
#define PG8_WAIT_V(n) asm volatile("s_waitcnt vmcnt(" #n ")" ::: "memory")
#define PG8_WAIT_L(n) asm volatile("s_waitcnt lgkmcnt(" #n ")" ::: "memory")
#define PG8_BAR __builtin_amdgcn_s_barrier()
#define PG8_SCHED __builtin_amdgcn_sched_barrier(0)
    Unit cur, nxt; int ui = 0;
    if (!S.next(0, cur)) return;
    f32x4 acc[2][2][4][2];
#pragma unroll
    for (int a = 0; a < 2; ++a)
#pragma unroll
        for (int b = 0; b < 2; ++b)
#pragma unroll
            for (int m = 0; m < 4; ++m)
#pragma unroll
                for (int n = 0; n < 2; ++n) acc[a][b][m][n] = (f32x4){0.f, 0.f, 0.f, 0.f};
    bf16x8 At[4][2], B0[2][2], B1[2][2];
    const char* cA = (const char*)g.A + (size_t)cur.pm * tstep; const char* cB = (const char*)g.Bt + (size_t)cur.pn * tstep;
    S.a_ready(cur);
    if constexpr (SP2) {
        PG8_STAGE(PG8_SB(0, 0), cB, voffB); PG8_STAGE(PG8_SB(0, 1), cB + hstep, voffB); PG8_STAGE(PG8_SA(0, 0), cA, voffA); PG8_STAGE(PG8_SA(0, 1), cA + hstep, voffA);
        if (wr == 1) PG8_BAR;
        PG8_WAIT_V(2); PG8_BAR;
        PG8_STAGE(PG8_SB(1, 0), cB + kstep, voffB); PG8_STAGE(PG8_SA(1, 0), cA + kstep, voffA); PG8_STAGE(PG8_SB(1, 1), cB + hstep + kstep, voffB);
        PG8_WAIT_V(6); PG8_BAR;
    } else {
        PG8_STAGE(PG8_SB(0, 0), cB, voffB); PG8_STAGE(PG8_SA(0, 0), cA, voffA); PG8_STAGE(PG8_SB(0, 1), cB + hstep, voffB); PG8_STAGE(PG8_SA(0, 1), cA + hstep, voffA);
        if (wr == 1) PG8_BAR;
        PG8_WAIT_V(4); PG8_BAR;
        PG8_STAGE(PG8_SB(1, 0), cB + kstep, voffB); PG8_STAGE(PG8_SA(1, 0), cA + kstep, voffA); PG8_STAGE(PG8_SB(1, 1), cB + hstep + kstep, voffB);
        PG8_WAIT_V(6); PG8_BAR;
    }
    for (;;) {
        const bool has_next = S.next(ui + 1, nxt);
        const char* nA = has_next ? (const char*)g.A + (size_t)nxt.pm * tstep : cA; const char* nB = has_next ? (const char*)g.Bt + (size_t)nxt.pn * tstep : cB;
        for (int t = 0; t < nt; t += 2) {
            const bool last = (t == nt - 2);
            const char* a1 = cA + (size_t)(t + 1) * kstep;
            const char* a2 = last ? nA : cA + (size_t)(t + 2) * kstep; const char* b2 = last ? nB : cB + (size_t)(t + 2) * kstep;
            const char* a3 = a2 + kstep; const char* b3 = b2 + kstep;
            if (last && has_next) S.a_ready(nxt);
            if constexpr (SP2) {
            PG8_LDB(B0, 0, 0); PG8_LDB(B1, 0, 1); PG8_SCHED; PG8_LDA(At, 0, 0); PG8_STAGE(PG8_SA(1, 1), a1 + hstep, voffA);
            PG8_WAIT_V(8); PG8_WAIT_L(0); PG8_BAR; PG8_MMA(0, 0, At, B0); PG8_MMA(0, 1, At, B1); PG8_BAR; PG8_SCHED;
            PG8_LDA(At, 0, 1); PG8_STAGE(PG8_SB(0, 0), b2, voffB); PG8_STAGE(PG8_SB(0, 1), b2 + hstep, voffB); PG8_STAGE(PG8_SA(0, 0), a2, voffA);
            PG8_WAIT_V(8); PG8_WAIT_L(0); PG8_BAR; PG8_MMA(1, 0, At, B0); PG8_MMA(1, 1, At, B1); PG8_BAR; PG8_SCHED;
            PG8_LDB(B0, 1, 0); PG8_LDB(B1, 1, 1); PG8_SCHED; PG8_LDA(At, 1, 0); PG8_STAGE(PG8_SA(0, 1), a2 + hstep, voffA);
            PG8_WAIT_V(8); PG8_WAIT_L(0); PG8_BAR; PG8_MMA(0, 0, At, B0); PG8_MMA(0, 1, At, B1); PG8_BAR; PG8_SCHED;
            PG8_LDA(At, 1, 1); PG8_STAGE(PG8_SB(1, 0), b3, voffB); PG8_STAGE(PG8_SB(1, 1), b3 + hstep, voffB); PG8_STAGE(PG8_SA(1, 0), a3, voffA);
            PG8_WAIT_V(8); PG8_WAIT_L(0); PG8_BAR; PG8_MMA(1, 0, At, B0); PG8_MMA(1, 1, At, B1); PG8_BAR; PG8_SCHED;
            } else {
            PG8_LDB(B0, 0, 0); PG8_SCHED; PG8_LDA(At, 0, 0); PG8_STAGE(PG8_SA(1, 1), a1 + hstep, voffA);
            PG8_WAIT_L(8); PG8_BAR; PG8_WAIT_L(0); PG8_MMA(0, 0, At, B0); PG8_BAR; PG8_SCHED;
            PG8_LDB(B1, 0, 1); PG8_STAGE(PG8_SB(0, 0), b2, voffB);
            PG8_BAR; PG8_WAIT_L(0); PG8_MMA(0, 1, At, B1); PG8_BAR;
            PG8_LDA(At, 0, 1); PG8_STAGE(PG8_SA(0, 0), a2, voffA);
            PG8_BAR; PG8_WAIT_L(0); PG8_MMA(1, 0, At, B0); PG8_BAR; PG8_SCHED;
            PG8_STAGE(PG8_SB(0, 1), b2 + hstep, voffB);
            PG8_WAIT_V(6); PG8_BAR; PG8_MMA(1, 1, At, B1); PG8_BAR;
            PG8_LDB(B0, 1, 0); PG8_SCHED; PG8_LDA(At, 1, 0); PG8_STAGE(PG8_SA(0, 1), a2 + hstep, voffA);
            PG8_WAIT_L(8); PG8_BAR; PG8_WAIT_L(0); PG8_MMA(0, 0, At, B0); PG8_BAR; PG8_SCHED;
            PG8_LDB(B1, 1, 1); PG8_STAGE(PG8_SB(1, 0), b3, voffB);
            PG8_BAR; PG8_WAIT_L(0); PG8_MMA(0, 1, At, B1); PG8_BAR;
            PG8_LDA(At, 1, 1); PG8_STAGE(PG8_SA(1, 0), a3, voffA);
            PG8_BAR; PG8_WAIT_L(0); PG8_MMA(1, 0, At, B0); PG8_BAR; PG8_SCHED;
            PG8_STAGE(PG8_SB(1, 1), b3 + hstep, voffB);
            PG8_WAIT_V(6); PG8_BAR; PG8_MMA(1, 1, At, B1); PG8_BAR;
            }
        }
        if constexpr (ALIGN_EPI) { if (wr == 0) PG8_BAR; }
        if constexpr (!Epi::AFTER_DRAIN) { E(acc, cur, wr, wc, fr, fq); S.done(cur); }
        if (!has_next) break;
#pragma unroll
        for (int a = 0; a < 2; ++a)
#pragma unroll
            for (int b = 0; b < 2; ++b)
#pragma unroll
                for (int m = 0; m < 4; ++m)
#pragma unroll
                    for (int n = 0; n < 2; ++n) acc[a][b][m][n] = (f32x4){0.f, 0.f, 0.f, 0.f};
        cur = nxt; cA = nA; cB = nB; ++ui;
        if constexpr (ALIGN_EPI) { if (wr == 1) PG8_BAR; }
    }
    PG8_WAIT_V(0);
    if constexpr (!ALIGN_EPI) { if (wr == 0) PG8_BAR; }
    PG8_BAR;
    if constexpr (Epi::AFTER_DRAIN) { E.fused(acc, cur, wr, wc, fr, fq, lds, wid, lane); S.done(cur); }
#undef PG8_SA
#undef PG8_SB
#undef PG8_STAGE
#undef PG8_LDA
#undef PG8_LDB
#undef PG8_MMA
#undef PG8_WAIT_V
#undef PG8_WAIT_L
#undef PG8_BAR
#undef PG8_SCHED
}
}

#define LAS __attribute__((address_space(3)))
typedef unsigned short bf16_t;
typedef short bf16x8 __attribute__((ext_vector_type(8)));
typedef short s16x4 __attribute__((ext_vector_type(4)));
typedef float f32x4 __attribute__((ext_vector_type(4)));
typedef float f32x16 __attribute__((ext_vector_type(16)));
typedef unsigned u32x4 __attribute__((ext_vector_type(4)));
typedef unsigned u32x2 __attribute__((ext_vector_type(2)));
typedef float f32x2_t __attribute__((ext_vector_type(2)));
typedef __bf16 bf16x2_t __attribute__((ext_vector_type(2)));

constexpr int MTOK = 16384, DMODEL = 1024, SEQL = 4096, DFF = 2816;
constexpr float EPS = 1e-6f;
constexpr float QSCALE_D = 0.17677669529663687f * 1.4426950408889634f;
constexpr float QSCALE_M = 0.125f * 1.4426950408889634f;
constexpr int LDS_BYTES = 147456;

constexpr size_t KiB = 1024, MiB = 1u << 20;
constexpr size_t WS_SSQ = 0, WS_GVST = 256 * KiB, WS_KBAR = 384 * KiB, WS_PAR = 512 * KiB, WS_BAR = 768 * KiB;
constexpr size_t WS_COS32 = 1 * MiB, WS_SIN32 = 1 * MiB + 256 * KiB, WS_COS64 = 2 * MiB, WS_SIN64 = 2 * MiB + 512 * KiB, WS_WSB = 3 * MiB;
constexpr size_t WS_WEI = 4 * MiB, WS_WEO = 10 * MiB, WS_WFI0 = 12 * MiB, WS_WFI1 = 23 * MiB, WS_WFO0 = 34 * MiB, WS_WFO1 = 34 * MiB + 5632 * KiB;
constexpr size_t WS_WOI = 45 * MiB, WS_WOO = 49 * MiB, WS_XB = 52 * MiB, WS_MIX = 84 * MiB, WS_BIG = 116 * MiB;
constexpr size_t WS_QK = WS_BIG, WS_VT = WS_BIG + 64 * MiB, WS_ACT = WS_BIG, WS_GU = WS_BIG, WS_GV = WS_BIG + 16 * MiB, WS_CP = WS_BIG + 32 * MiB;
constexpr size_t WS_END = 212 * MiB;

struct Args { const float* in[27]; float* out; unsigned char* ws; };

__device__ __forceinline__ unsigned cvtpk(float lo, float hi) { f32x2_t v = {lo, hi}; bf16x2_t b = __builtin_convertvector(v, bf16x2_t); return __builtin_bit_cast(unsigned, b); }
__device__ __forceinline__ bf16_t f2bf(float f) { return (bf16_t)(cvtpk(f, 0.f) & 0xffffu); }
__device__ __forceinline__ float bf2f(bf16_t u) { return __uint_as_float((unsigned)u << 16); }
__device__ __forceinline__ float bflo(unsigned w) { return __uint_as_float(w << 16); }
__device__ __forceinline__ float bfhi(unsigned w) { return __uint_as_float(w & 0xffff0000u); }
__device__ __forceinline__ float dot4(f32x4 a) { return (a[0] * a[0] + a[1] * a[1]) + (a[2] * a[2] + a[3] * a[3]); }
__device__ __forceinline__ float sum4(f32x4 a) { return (a[0] + a[1]) + (a[2] + a[3]); }
__device__ __forceinline__ u32x2 pk4(f32x4 v) { u32x2 w; w.x = cvtpk(v[0], v[1]); w.y = cvtpk(v[2], v[3]); return w; }
__device__ __forceinline__ float wave_sum(float v) {
#pragma unroll
    for (int o = 1; o < 64; o <<= 1) v += __shfl_xor(v, o);
    return v;
}
__device__ __forceinline__ float hswap_max(float v) { auto rr = __builtin_amdgcn_permlane32_swap(__float_as_uint(v), __float_as_uint(v), false, false); return fmaxf(__uint_as_float(rr[0]), __uint_as_float(rr[1])); }
__device__ __forceinline__ float hswap_sum(float v) { auto rr = __builtin_amdgcn_permlane32_swap(__float_as_uint(v), __float_as_uint(v), false, false); return __uint_as_float(rr[0]) + __uint_as_float(rr[1]); }
__device__ __forceinline__ float fast_sigmoid(float x) { return __builtin_amdgcn_rcpf(1.f + __expf(-x)); }
#define MFMA32(a, b, c) __builtin_amdgcn_mfma_f32_32x32x16_bf16((a), (b), (c), 0, 0, 0)
__device__ __forceinline__ int mk_tid(int wid_s) { int lane_; asm volatile("v_mbcnt_lo_u32_b32 %0, -1, 0\n\tv_mbcnt_hi_u32_b32 %0, -1, %0" : "=v"(lane_)); return wid_s * 64 + lane_; }
__device__ __forceinline__ int crow(int reg, int h) { return (reg & 3) + 8 * (reg >> 2) + 4 * h; }


constexpr int PB_QN = 0, PB_KN = 32, PB_MQN = 64, PB_MKN = 128, PB_SUBLN = 192, PB_OBIAS = 256, PB_GLNG = 2304, PB_GLNB = 2816, PB_GBS = 3328, PB_CW = 4352, PB_CB = 20224, PB_CLNG = 20736, PB_CLNB = 21248, PB_LAM = 21760;
struct EpiDiffQK {
    static constexpr bool PERM = false, AFTER_DRAIN = false;
    unsigned char* ws;
    __device__ __forceinline__ void operator()(const f32x4 (&acc)[2][2][4][2], const pg8::Unit& u, int wr, int wc, int fr, int fq) const {
        const int type = u.pn >> 1, head = (u.pn & 1) * 4 + wc;
        const int rowb = u.pm * 256 + wr * 64 + fr;
        const float* ssq = (const float*)(ws + WS_SSQ); bf16_t* QK = (bf16_t*)(ws + WS_QK);
        const float* cos32 = (const float*)(ws + WS_COS32); const float* sin32 = (const float*)(ws + WS_SIN32);
        const float* g = (const float*)(ws + WS_PAR) + (type == 0 ? PB_QN : PB_KN); const float qs = type == 0 ? QSCALE_D : 1.f;
        const f32x4 g0 = *(const f32x4*)(g + 4 * fq), g1 = *(const f32x4*)(g + 16 + 4 * fq);
#pragma unroll
        for (int ai = 0; ai < 2; ++ai)
#pragma unroll
            for (int m = 0; m < 4; ++m) {
                const int row = rowb + ai * 128 + m * 16, t = row & (SEQL - 1);
                const float rs = rsqrtf(ssq[row] * (1.f / DMODEL) + EPS);
                const f32x4 c = *(const f32x4*)(cos32 + t * 16 + 4 * fq), s = *(const f32x4*)(sin32 + t * 16 + 4 * fq);
#pragma unroll
                for (int bj = 0; bj < 2; ++bj) {
                    const f32x4 v0 = acc[ai][bj][m][0] * rs, v1 = acc[ai][bj][m][1] * rs;
                    float ss = dot4(v0) + dot4(v1); ss += __shfl_xor(ss, 16); ss += __shfl_xor(ss, 32);
                    const float r = rsqrtf(ss * (1.f / 32.f) + EPS);
                    const f32x4 y0 = v0 * r * g0, y1 = v1 * r * g1;
                    const f32x4 o0 = (y0 * c - y1 * s) * qs, o1 = (y1 * c + y0 * s) * qs;
                    bf16_t* dst = QK + (size_t)row * 2048 + type * 512 + head * 64 + bj * 32 + 8 * fq;
                    const u32x2 p0 = pk4(o0), p1 = pk4(o1); *(u32x4*)dst = (u32x4){p0.x, p0.y, p1.x, p1.y};
                }
                asm volatile("" ::: "memory");
            }
    }
};
struct EpiMobaQK {
    static constexpr bool PERM = false, AFTER_DRAIN = false;
    unsigned char* ws;
    __device__ __forceinline__ void operator()(const f32x4 (&acc)[2][2][4][2], const pg8::Unit& u, int wr, int wc, int fr, int fq) const {
        const int type = u.pn >> 1, head = (u.pn & 1) * 4 + wc;
        const int rowb = u.pm * 256 + wr * 64 + fr;
        const float* ssq = (const float*)(ws + WS_SSQ); bf16_t* QK = (bf16_t*)(ws + WS_QK);
        const float* cos64 = (const float*)(ws + WS_COS64); const float* sin64 = (const float*)(ws + WS_SIN64);
        const float* g = (const float*)(ws + WS_PAR) + (type == 0 ? PB_MQN : PB_MKN); const float qs = type == 0 ? QSCALE_M : 1.f;
        f32x4 gg[2][2], cs[2][2];
#pragma unroll
        for (int bj = 0; bj < 2; ++bj)
#pragma unroll
            for (int n = 0; n < 2; ++n) { gg[bj][n] = *(const f32x4*)(g + 32 * bj + 16 * n + 4 * fq); cs[bj][n] = (f32x4){0.f, 0.f, 0.f, 0.f}; }
#pragma unroll
        for (int ai = 0; ai < 2; ++ai)
#pragma unroll
            for (int m = 0; m < 4; ++m) {
                const int row = rowb + ai * 128 + m * 16, t = row & (SEQL - 1);
                const float rs = rsqrtf(ssq[row] * (1.f / DMODEL) + EPS);
                f32x4 v[2][2]; float ss = 0.f;
#pragma unroll
                for (int bj = 0; bj < 2; ++bj)
#pragma unroll
                    for (int n = 0; n < 2; ++n) { v[bj][n] = acc[ai][bj][m][n] * rs; ss += dot4(v[bj][n]); }
                ss += __shfl_xor(ss, 16); ss += __shfl_xor(ss, 32);
                const float r = rsqrtf(ss * (1.f / 64.f) + EPS);
                bf16_t* dst = QK + (size_t)row * 2048 + 1024 + type * 512 + head * 64 + 16 * fq;
                u32x4 w0, w1;
#pragma unroll
                for (int n = 0; n < 2; ++n) {
                    const f32x4 c = *(const f32x4*)(cos64 + t * 32 + 16 * n + 4 * fq), s = *(const f32x4*)(sin64 + t * 32 + 16 * n + 4 * fq);
                    const f32x4 y0 = v[0][n] * r * gg[0][n], y1 = v[1][n] * r * gg[1][n];
                    const f32x4 o0 = (y0 * c - y1 * s) * qs, o1 = (y1 * c + y0 * s) * qs;
                    const u32x2 p0 = pk4(o0), p1 = pk4(o1);
                    if (n == 0) { w0.x = p0.x; w0.y = p0.y; w1.x = p1.x; w1.y = p1.y; } else { w0.z = p0.x; w0.w = p0.y; w1.z = p1.x; w1.w = p1.y; }
                    cs[0][n] += o0; cs[1][n] += o1;
                }
                *(u32x4*)dst = w0; *(u32x4*)(dst + 8) = w1;
                asm volatile("" ::: "memory");
            }
        if (type == 1) {
            float* kbar = (float*)(ws + WS_KBAR);
#pragma unroll
            for (int bj = 0; bj < 2; ++bj)
#pragma unroll
                for (int n = 0; n < 2; ++n)
#pragma unroll
                    for (int j = 0; j < 4; ++j) {
                        float x = cs[bj][n][j];
                        x += __shfl_xor(x, 1); x += __shfl_xor(x, 2); x += __shfl_xor(x, 4); x += __shfl_xor(x, 8);
                        if (fr == 0) unsafeAtomicAdd(kbar + ((size_t)u.pm * 8 + head) * 64 + 16 * fq + 8 * bj + 4 * n + j, x);
                    }
        }
    }
};
struct EpiV {
    static constexpr bool PERM = false, AFTER_DRAIN = true;
    unsigned char* ws;
    __device__ __forceinline__ void fused(f32x4 (&acc)[2][2][4][2], const pg8::Unit& u, int wr, int wc, int fr, int fq, LAS unsigned char* lds, int wid, int lane) const {
        constexpr int TP = 264;
        LAS bf16_t* T = (LAS bf16_t*)lds;
        const float* ssq = (const float*)(ws + WS_SSQ);
        const int rowb = u.pm * 256 + wr * 64 + fr;
#pragma unroll
        for (int ai = 0; ai < 2; ++ai)
#pragma unroll
            for (int m = 0; m < 4; ++m) {
                const int row = rowb + ai * 128 + m * 16, tl = ai * 128 + wr * 64 + m * 16 + fr;
                const float rs = rsqrtf(ssq[row] * (1.f / DMODEL) + EPS);
#pragma unroll
                for (int bj = 0; bj < 2; ++bj)
#pragma unroll
                    for (int n = 0; n < 2; ++n) {
                        const f32x4 v = acc[ai][bj][m][n] * rs; const int dl = 64 * wc + 32 * bj + 16 * n + 4 * fq;
                        const u32x2 w = pk4(v);
                        T[(dl + 0) * TP + tl] = (bf16_t)(w.x & 0xffffu); T[(dl + 1) * TP + tl] = (bf16_t)(w.x >> 16);
                        T[(dl + 2) * TP + tl] = (bf16_t)(w.y & 0xffffu); T[(dl + 3) * TP + tl] = (bf16_t)(w.y >> 16);
                    }
            }
        asm volatile("s_waitcnt lgkmcnt(0)" ::: "memory"); __builtin_amdgcn_s_barrier(); asm volatile("" ::: "memory");
        const int tid = wid * 64 + lane, which = u.pn >> 1, b = u.pm >> 4, t0 = (u.pm & 15) * 256;
        bf16_t* base = (bf16_t*)(ws + WS_VT) + ((size_t)((which * 4 + b) * 8 + (u.pn & 1) * 4) * 64) * SEQL + t0;
#pragma unroll 4
        for (int p = 0; p < 16; ++p) {
            const int rd = p * 16 + (tid >> 5), ch = tid & 31;
            const u32x4 w = *(LAS const u32x4*)(T + rd * TP + ch * 8);
            *(u32x4*)(base + (size_t)rd * SEQL + ch * 8) = w;
        }
    }
};

struct EpiResid {
    static constexpr bool PERM = true, AFTER_DRAIN = false;
    const bf16_t* xin; float* xout; bf16_t* xb; float* ssq;
    __device__ __forceinline__ void operator()(const f32x4 (&acc)[2][2][4][2], const pg8::Unit& u, int wr, int wc, int fr, int fq) const {
        const int rowb = u.pm * 256 + wr * 64 + fr, colb = u.pn * 256 + wc * 32 + 8 * fq;
#pragma unroll
        for (int ai = 0; ai < 2; ++ai)
#pragma unroll
            for (int m = 0; m < 4; ++m) {
                const int row = rowb + ai * 128 + m * 16; float ss = 0.f;
#pragma unroll
                for (int bj = 0; bj < 2; ++bj) {
                    const size_t off = (size_t)row * DMODEL + colb + bj * 128;
                    const u32x4 xo = *(const u32x4*)(xin + off);
                    f32x4 x0 = acc[ai][bj][m][0], x1 = acc[ai][bj][m][1];
                    x0[0] += bflo(xo.x); x0[1] += bfhi(xo.x); x0[2] += bflo(xo.y); x0[3] += bfhi(xo.y);
                    x1[0] += bflo(xo.z); x1[1] += bfhi(xo.z); x1[2] += bflo(xo.w); x1[3] += bfhi(xo.w);
                    if (xout) { *(f32x4*)(xout + off) = x0; *(f32x4*)(xout + off + 4) = x1; }
                    if (xb) { const u32x2 p0 = pk4(x0), p1 = pk4(x1); *(u32x4*)(xb + off) = (u32x4){p0.x, p0.y, p1.x, p1.y}; }
                    ss += dot4(x0) + dot4(x1);
                }
                if (ssq) { ss += __shfl_xor(ss, 16); ss += __shfl_xor(ss, 32); if (fq == 0) unsafeAtomicAdd(ssq + row, ss); }
                asm volatile("" ::: "memory");
            }
    }
};

struct EpiSwiglu {
    static constexpr bool PERM = true, AFTER_DRAIN = false;
    const float* ssq; bf16_t* act;
    __device__ __forceinline__ void operator()(const f32x4 (&acc)[2][2][4][2], const pg8::Unit& u, int wr, int wc, int fr, int fq) const {
        const int rowb = u.pm * 256 + wr * 64 + fr, colb = u.pn * 128 + wc * 32 + 8 * fq;
#pragma unroll
        for (int ai = 0; ai < 2; ++ai)
#pragma unroll
            for (int m = 0; m < 4; ++m) {
                const int row = rowb + ai * 128 + m * 16;
                const float rs = rsqrtf(ssq[row] * (1.f / DMODEL) + EPS);
                u32x4 w;
#pragma unroll
                for (int n = 0; n < 2; ++n) {
                    const f32x4 g = acc[ai][0][m][n] * rs, uu = acc[ai][1][m][n] * rs; f32x4 a;
#pragma unroll
                    for (int j = 0; j < 4; ++j) a[j] = g[j] * fast_sigmoid(g[j]) * uu[j];
                    const u32x2 p = pk4(a); if (n == 0) { w.x = p.x; w.y = p.y; } else { w.z = p.x; w.w = p.y; }
                }
                *(u32x4*)(act + (size_t)row * DFF + colb) = w;
                asm volatile("" ::: "memory");
            }
    }
};

struct EpiOddIn {
    static constexpr bool PERM = true, AFTER_DRAIN = false;
    unsigned char* ws;
    __device__ __forceinline__ void operator()(const f32x4 (&acc)[2][2][4][2], const pg8::Unit& u, int wr, int wc, int fr, int fq) const {
        const int rowb = u.pm * 256 + wr * 64 + fr;
        const float* ssq = (const float*)(ws + WS_SSQ) + 2 * MTOK; const float* bias = (const float*)(ws + WS_PAR) + PB_OBIAS;
        bf16_t* GU = (bf16_t*)(ws + WS_GU); bf16_t* GV = (bf16_t*)(ws + WS_GV); bf16_t* CP = (bf16_t*)(ws + WS_CP); float* gvst = (float*)(ws + WS_GVST);
        if (u.pn < 4) {
            const int colb = u.pn * 256 + wc * 32 + 8 * fq;
            bf16_t* dstb = u.pn < 2 ? GU : GV; const int cadj = u.pn < 2 ? 0 : 512;
#pragma unroll
            for (int ai = 0; ai < 2; ++ai)
#pragma unroll
                for (int m = 0; m < 4; ++m) {
                    const int row = rowb + ai * 128 + m * 16;
                    const float rs = rsqrtf(ssq[row] * (1.f / DMODEL) + EPS); float s1 = 0.f, s2 = 0.f;
#pragma unroll
                    for (int bj = 0; bj < 2; ++bj) {
                        u32x4 w;
#pragma unroll
                        for (int n = 0; n < 2; ++n) {
                            const int col = colb + bj * 128 + n * 4;
                            const f32x4 x = acc[ai][bj][m][n] * rs + *(const f32x4*)(bias + col); f32x4 y;
#pragma unroll
                            for (int j = 0; j < 4; ++j) { const float z = 1.5957691216057308f * (x[j] + 0.044715f * x[j] * x[j] * x[j]); y[j] = x[j] * fast_sigmoid(z); }
                            const u32x2 p = pk4(y); if (n == 0) { w.x = p.x; w.y = p.y; } else { w.z = p.x; w.w = p.y; }
                            s1 += sum4(y); s2 += dot4(y);
                        }
                        *(u32x4*)(dstb + (size_t)row * 512 + colb + bj * 128 - cadj) = w;
                    }
                    if (u.pn >= 2) {
                        s1 += __shfl_xor(s1, 16); s1 += __shfl_xor(s1, 32); s2 += __shfl_xor(s2, 16); s2 += __shfl_xor(s2, 32);
                        if (fq == 0) { unsafeAtomicAdd(gvst + 2 * row, s1); unsafeAtomicAdd(gvst + 2 * row + 1, s2); }
                    }
                    asm volatile("" ::: "memory");
                }
        } else {
            const int offb = (u.pn - 4) * 128 + wc * 32 + 8 * fq;
#pragma unroll
            for (int ai = 0; ai < 2; ++ai)
#pragma unroll
                for (int m = 0; m < 4; ++m) {
                    const int row = rowb + ai * 128 + m * 16;
                    const float rs = rsqrtf(ssq[row] * (1.f / DMODEL) + EPS);
                    u32x4 w;
#pragma unroll
                    for (int n = 0; n < 2; ++n) {
                        const int off = offb + n * 4;
                        const f32x4 a = acc[ai][0][m][n] * rs + *(const f32x4*)(bias + 1024 + off), gt = acc[ai][1][m][n] * rs + *(const f32x4*)(bias + 1536 + off); f32x4 y;
#pragma unroll
                        for (int j = 0; j < 4; ++j) y[j] = a[j] * fast_sigmoid(gt[j]);
                        const u32x2 p = pk4(y); if (n == 0) { w.x = p.x; w.y = p.y; } else { w.z = p.x; w.w = p.y; }
                    }
                    *(u32x4*)(CP + (size_t)row * 512 + offb) = w;
                    asm volatile("" ::: "memory");
                }
        }
    }
};

__device__ __forceinline__ int map_row(int mode, int n0) {
    if (mode == 1) { const int seg = n0 >> 9, nseg = seg == 2 ? 4 : (seg == 3 ? 2 : (seg == 4 ? 3 : seg)), l = n0 & 511, pl = l >> 8, l2 = l & 255, wc = l2 >> 6, bj = (l2 >> 5) & 1;
                     return nseg * 512 + pl * 256 + bj * 128 + wc * 32; }
    if (mode == 2) { if (n0 < DFF) return (n0 >> 7) * 256 + (n0 & 127); const int n1 = n0 - DFF; return (n1 >> 7) * 256 + 128 + (n1 & 127); }
    if (mode == 3) { if (n0 < 1024) return n0; if (n0 < 1536) { const int n1 = n0 - 1024; return (4 + (n1 >> 7)) * 256 + (n1 & 127); }
                     const int n1 = n0 - 1536; return (4 + (n1 >> 7)) * 256 + 128 + (n1 & 127); }
    return n0;
}
constexpr int TRP = 65;
__device__ __forceinline__ void tr_item(const float* W, int K, int N, bf16_t* WT, int mode, const float* gk, LAS float* scr, int item, int lane) {
    const int nblk = N / 64, kb = item / nblk, nb = item % nblk, k0 = 64 * kb, n0 = 64 * nb;
    f32x4 v[16];
#pragma unroll
    for (int i = 0; i < 16; ++i) { const int kk = 4 * i + (lane >> 4); v[i] = *(const f32x4*)(W + (size_t)(k0 + kk) * N + n0 + (lane & 15) * 4); }
#pragma unroll
    for (int i = 0; i < 16; ++i) { const int kk = 4 * i + (lane >> 4); f32x4 w = v[i]; if (gk) w = w * gk[k0 + kk]; LAS float* d = scr + kk * TRP + (lane & 15) * 4;
        d[0] = w[0]; d[1] = w[1]; d[2] = w[2]; d[3] = w[3]; }
    asm volatile("s_waitcnt lgkmcnt(0)" ::: "memory");
    const int c = lane & 7, nn = lane >> 3;
#pragma unroll
    for (int j = 0; j < 8; ++j) {
        const int n = nn + 8 * j;
        const LAS float* s = scr + (8 * c) * TRP + n;
        u32x4 o; o.x = cvtpk(s[0 * TRP], s[1 * TRP]); o.y = cvtpk(s[2 * TRP], s[3 * TRP]); o.z = cvtpk(s[4 * TRP], s[5 * TRP]); o.w = cvtpk(s[6 * TRP], s[7 * TRP]);
        *(u32x4*)(WT + (size_t)(map_row(mode, n0 + (n & 32)) + (n & 31)) * K + k0 + 8 * c) = o;
    }
    asm volatile("s_waitcnt lgkmcnt(0)" ::: "memory");
}

constexpr int I_EI = 16 * 48, I_EO = 16 * 16, I_FI = 16 * 88, I_FO = 44 * 16, I_OI = 16 * 32, I_OO = 16 * 16;
__device__ __forceinline__ void convert_late(const Args& a, unsigned char* ws, LAS unsigned char* lds, int gw, int nw, int wid) {
    const int lane = mk_tid(wid) & 63;
    LAS float* scr = (LAS float*)(lds + wid * (64 * TRP * 4));
    constexpr int NITEMS = I_FI + I_FO + I_OI + I_OO;
    for (int it = gw; it < NITEMS; it += nw) {
        int r = it;
        if (r < I_FI) { tr_item(a.in[3] + (size_t)1024 * 5632, 1024, 5632, (bf16_t*)(ws + WS_WFI1), 2, a.in[2] + 1024, scr, r, lane); continue; } r -= I_FI;
        if (r < I_FO) { tr_item(a.in[4] + (size_t)2816 * 1024, 2816, 1024, (bf16_t*)(ws + WS_WFO1), 0, nullptr, scr, r, lane); continue; } r -= I_FO;
        if (r < I_OI) { tr_item(a.in[16], 1024, 2048, (bf16_t*)(ws + WS_WOI), 3, a.in[1] + 1024, scr, r, lane); continue; } r -= I_OI;
        tr_item(a.in[18], 1024, 1024, (bf16_t*)(ws + WS_WOO), 0, nullptr, scr, r, lane);
    }
}
__device__ __forceinline__ void prologue(const Args& a, LAS unsigned char* lds, int vcu, int G, int wid) {
    const int tid = mk_tid(wid), lane = tid & 63;
    unsigned char* ws = a.ws;
    LAS float* scr = (LAS float*)(lds + wid * (64 * TRP * 4));
    const int gw = vcu * 8 + wid, NGW = G * 8;
    constexpr int NITEMS = I_EI + I_EO + I_FI + I_FO;
    for (int it = gw; it < NITEMS; it += NGW) {
        int r = it;
        if (r < I_EI) { tr_item(a.in[5], 1024, 3072, (bf16_t*)(ws + WS_WEI), 1, a.in[1], scr, r, lane); continue; } r -= I_EI;
        if (r < I_EO) { tr_item(a.in[6], 1024, 1024, (bf16_t*)(ws + WS_WEO), 0, nullptr, scr, r, lane); continue; } r -= I_EO;
        if (r < I_FI) { tr_item(a.in[3], 1024, 5632, (bf16_t*)(ws + WS_WFI0), 2, a.in[2], scr, r, lane); continue; } r -= I_FI;
        tr_item(a.in[4], 2816, 1024, (bf16_t*)(ws + WS_WFO0), 0, nullptr, scr, r, lane);
    }
    float* ssq = (float*)(ws + WS_SSQ); bf16_t* XB = (bf16_t*)(ws + WS_XB);
    for (int m = gw; m < MTOK; m += NGW) {
        const f32x4* xr = (const f32x4*)(a.in[0] + (size_t)m * DMODEL) + lane; u32x2* o8 = (u32x2*)(XB + (size_t)m * DMODEL) + lane; float s = 0.f;
#pragma unroll
        for (int j = 0; j < 4; ++j) { const f32x4 v = xr[64 * j]; s += dot4(v); o8[64 * j] = pk4(v); }
        s = wave_sum(s); if (lane == 0) ssq[m] = s;
    }
    const int gt = vcu * 512 + tid, NGT = G * 512;
    for (int i = 16384 + gt; i < 131072; i += NGT) ssq[i] = 0.f;
    for (int i = gt; i < SEQL * 48; i += NGT) {
        const int t = i / 48, e = i % 48; const bool small = e < 16; const int fi = small ? e : e - 16;
        const float inv = 1.0f / powf(10000.0f, small ? (float)fi * (1.f / 16.f) : (float)fi * (1.f / 32.f));
        const float ang = (float)t * inv;
        const double ad = (double)ang, n = rint(ad * 0.15915494309189535), rr = ad - n * 6.283185307179586;
        const float rf = (float)rr, cv = __cosf(rf), sv = __sinf(rf);
        if (small) { ((float*)(ws + WS_COS32))[t * 16 + fi] = cv; ((float*)(ws + WS_SIN32))[t * 16 + fi] = sv; }
        else { ((float*)(ws + WS_COS64))[t * 32 + fi] = cv; ((float*)(ws + WS_SIN64))[t * 32 + fi] = sv; }
    }
    for (int i = gt; i < 8 * 128 * 128; i += NGT) { const int t = (i >> 7) & 127, s = i & 127; ((bf16_t*)(ws + WS_WSB))[i] = s <= t ? f2bf(a.in[21][i]) : (bf16_t)0; }
    if (vcu == 0 && wid == 0) {
        float p1 = 0.f, p2 = 0.f;
        if (lane < 32) { p1 = a.in[9][lane] * a.in[10][lane]; p2 = a.in[11][lane] * a.in[12][lane]; }
        p1 = wave_sum(p1); p2 = wave_sum(p2);
        if (lane == 0) ((float*)(ws + WS_PAR))[PB_LAM] = expf(p1) - expf(p2) + 0.2f;
    }
    {
        float* pb = (float*)(ws + WS_PAR);
        for (int i = gt; i < PB_LAM; i += NGT) {
            float v;
            if (i < PB_KN) v = a.in[7][i - PB_QN]; else if (i < PB_MQN) v = a.in[8][i - PB_KN]; else if (i < PB_MKN) v = a.in[14][i - PB_MQN]; else if (i < PB_SUBLN) v = a.in[15][i - PB_MKN];
            else if (i < PB_OBIAS) v = a.in[13][i - PB_SUBLN]; else if (i < PB_GLNG) v = a.in[17][i - PB_OBIAS]; else if (i < PB_GLNB) v = a.in[19][i - PB_GLNG]; else if (i < PB_GBS) v = a.in[20][i - PB_GLNB];
            else if (i < PB_CW) v = a.in[22][i - PB_GBS]; else if (i < PB_CB) v = a.in[23][i - PB_CW]; else if (i < PB_CLNG) v = a.in[24][i - PB_CB]; else if (i < PB_CLNB) v = a.in[25][i - PB_CLNG]; else v = a.in[26][i - PB_CLNB];
            pb[i] = v;
        }
    }
}

constexpr int KPITCH = 144, VPITCH = 272, KBUF = 128 * KPITCH, VBUF = 64 * VPITCH;
template <bool DIFF>
__device__ __forceinline__ void attn_unit(LAS unsigned char* lds, unsigned char* ws, int b, int hd, int qb, int wid) {
    const float* subln_g = (const float*)(ws + WS_PAR) + PB_SUBLN; bf16_t* MIX = (bf16_t*)(ws + WS_MIX);
    constexpr int NM = DIFF ? 2 : 1;
    const int tid = mk_tid(wid), lane = tid & 63, r = lane & 31, h = lane >> 5;
    const bf16_t* QK = (const bf16_t*)(ws + WS_QK); const bf16_t* VT = (const bf16_t*)(ws + WS_VT);
    const int q0 = qb * 256, qw = q0 + 32 * wid, qrow = qw + r;
    const size_t grow = (size_t)b * SEQL + qrow;
    const bf16_t* Qp = QK + grow * 2048 + (DIFF ? 0 : 1024) + hd * 64;
    const bf16_t* Kg = QK + (size_t)b * SEQL * 2048 + (DIFF ? 512 : 1536) + hd * 64;
    const bf16_t* Vg = VT + ((size_t)(((DIFF ? 0 : 1) * 4 + b) * 8 + hd) * 64) * SEQL;
    bf16x8 qf[4];
#pragma unroll
    for (int i = 0; i < 4; ++i) qf[i] = *(const bf16x8*)(Qp + 16 * i + 8 * h);
    unsigned sel = 0u;
    if (!DIFF) {
        float qv[32];
#pragma unroll
        for (int i = 0; i < 4; ++i) { const u32x4 w = *(const u32x4*)(Qp + 32 * h + 8 * i);
            qv[8 * i + 0] = bflo(w.x); qv[8 * i + 1] = bfhi(w.x); qv[8 * i + 2] = bflo(w.y); qv[8 * i + 3] = bfhi(w.y);
            qv[8 * i + 4] = bflo(w.z); qv[8 * i + 5] = bfhi(w.z); qv[8 * i + 6] = bflo(w.w); qv[8 * i + 7] = bfhi(w.w); }
        float g[15];
        const float* kb0 = (const float*)(ws + WS_KBAR) + ((size_t)(b * 16) * 8 + hd) * 64 + 32 * h;
#pragma unroll
        for (int n = 0; n < 15; ++n) {
            float acc = 0.f;
            if (n < qb) {
                const float* kb = kb0 + (size_t)n * 512;
#pragma unroll
                for (int i = 0; i < 8; ++i) { const f32x4 kv = *(const f32x4*)(kb + 4 * i); acc += qv[4 * i] * kv[0] + qv[4 * i + 1] * kv[1] + qv[4 * i + 2] * kv[2] + qv[4 * i + 3] * kv[3]; }
                acc = hswap_sum(acc);
            }
            g[n] = acc;
        }
#pragma unroll
        for (int pass = 0; pass < 3; ++pass) {
            float best = -INFINITY; int bi = -1;
#pragma unroll
            for (int n = 0; n < 15; ++n) { const bool ok = (n < qb) && !((sel >> n) & 1u) && (g[n] > best); best = ok ? g[n] : best; bi = ok ? n : bi; }
            if (bi >= 0) sel |= 1u << bi;
        }
    }
    f32x16 o[NM][2]; float lrun[NM];
#pragma unroll
    for (int mp = 0; mp < NM; ++mp) { lrun[mp] = 0.f;
#pragma unroll
        for (int d = 0; d < 2; ++d)
#pragma unroll
            for (int i = 0; i < 16; ++i) o[mp][d][i] = 0.f; }
    const int nT = (q0 + 256) / 128;
    const int krow = tid >> 2, kch = tid & 3, vrow = tid >> 3, vch = tid & 7;
    const bf16_t* ksrc = Kg + (size_t)krow * 2048 + kch * 16;
    const bf16_t* vsrc = Vg + (size_t)vrow * SEQL + vch * 16;
    LAS unsigned char* kdst = lds + krow * KPITCH + kch * 32;
    LAS unsigned char* vdst = lds + 2 * KBUF + vrow * VPITCH + vch * 32;
    u32x4 kreg0 = *(const u32x4*)ksrc, kreg1 = *(const u32x4*)(ksrc + 8), vreg0 = *(const u32x4*)vsrc, vreg1 = *(const u32x4*)(vsrc + 8);
#define ATT_STAGE(bo) do { LAS unsigned char* kd_ = kdst + (bo) * KBUF; LAS unsigned char* vd_ = vdst + (bo) * VBUF; \
        *(LAS u32x4*)kd_ = kreg0; *(LAS u32x4*)(kd_ + 16) = kreg1; \
        *(LAS u32x4*)vd_ = (u32x4){vreg0.x, vreg0.y, vreg1.x, vreg1.y}; *(LAS u32x4*)(vd_ + 16) = (u32x4){vreg0.z, vreg0.w, vreg1.z, vreg1.w}; } while (0)
    ATT_STAGE(0);
    __syncthreads();
    for (int t = 0; t < nT; ++t) {
        const int buf = t & 1;
        if (t + 1 < nT) { const bf16_t* kp_ = ksrc + (size_t)(t + 1) * 128 * 2048; const bf16_t* vp_ = vsrc + (t + 1) * 128;
            kreg0 = *(const u32x4*)kp_; kreg1 = *(const u32x4*)(kp_ + 8); vreg0 = *(const u32x4*)vp_; vreg1 = *(const u32x4*)(vp_ + 8); }
#pragma nounroll
        for (int sb = 0; sb < 2; ++sb) {
        const int kv0 = t * 128 + sb * 64, tt = 2 * t + sb;
        bool active = kv0 <= qw + 31;
        const bool past = !DIFF && (tt >> 2) < qb;
        const bool use = past ? ((sel >> (tt >> 2)) & 1u) != 0u : true;
        if (past) active = active && (__ballot(use) != 0ull);
        if (active) {
            LAS const unsigned char* Kt = lds + buf * KBUF + sb * (64 * KPITCH); LAS const unsigned char* Vt = lds + 2 * KBUF + buf * VBUF + sb * 128;
            f32x16 s[NM][2];
#pragma unroll
            for (int kvb = 0; kvb < 2; ++kvb) {
                LAS const unsigned char* kp = Kt + (kvb * 32 + r) * KPITCH + h * 16;
                bf16x8 kf[4];
#pragma unroll
                for (int i = 0; i < 4; ++i) kf[i] = *(LAS const bf16x8*)(kp + 32 * i);
                f32x16 z;
#pragma unroll
                for (int i = 0; i < 16; ++i) z[i] = 0.f;
                if (DIFF) { s[0][kvb] = MFMA32(kf[0], qf[0], z); s[0][kvb] = MFMA32(kf[1], qf[1], s[0][kvb]);
                            s[NM - 1][kvb] = MFMA32(kf[2], qf[2], z); s[NM - 1][kvb] = MFMA32(kf[3], qf[3], s[NM - 1][kvb]); }
                else { s[0][kvb] = MFMA32(kf[0], qf[0], z); s[0][kvb] = MFMA32(kf[1], qf[1], s[0][kvb]); s[0][kvb] = MFMA32(kf[2], qf[2], s[0][kvb]); s[0][kvb] = MFMA32(kf[3], qf[3], s[0][kvb]); }
            }
            if (kv0 + 63 > qw) {
#pragma unroll
                for (int kvb = 0; kvb < 2; ++kvb)
#pragma unroll
                    for (int i = 0; i < 16; ++i) { const bool dead = kv0 + 32 * kvb + crow(i, h) > qrow;
#pragma unroll
                        for (int mp = 0; mp < NM; ++mp) s[mp][kvb][i] = dead ? -INFINITY : s[mp][kvb][i]; }
            }
#pragma unroll
            for (int mp = 0; mp < NM; ++mp) {
                float rsum = 0.f;
#pragma unroll
                for (int kvb = 0; kvb < 2; ++kvb)
#pragma unroll
                    for (int i = 0; i < 16; ++i) { const float p = __builtin_amdgcn_exp2f(s[mp][kvb][i]); s[mp][kvb][i] = p; rsum += p; }
                lrun[mp] += use ? rsum : 0.f;
            }
#pragma unroll
            for (int kvb = 0; kvb < 2; ++kvb)
#pragma unroll
                for (int ss = 0; ss < 2; ++ss) {
                    bf16x8 pb[NM];
#pragma unroll
                    for (int mp = 0; mp < NM; ++mp) { u32x4 w; w.x = cvtpk(s[mp][kvb][8 * ss + 0], s[mp][kvb][8 * ss + 1]); w.y = cvtpk(s[mp][kvb][8 * ss + 2], s[mp][kvb][8 * ss + 3]);
                        w.z = cvtpk(s[mp][kvb][8 * ss + 4], s[mp][kvb][8 * ss + 5]); w.w = cvtpk(s[mp][kvb][8 * ss + 6], s[mp][kvb][8 * ss + 7]);
                        if (past) { w.x = use ? w.x : 0u; w.y = use ? w.y : 0u; w.z = use ? w.z : 0u; w.w = use ? w.w : 0u; }
                        pb[mp] = __builtin_bit_cast(bf16x8, w); }
#pragma unroll
                    for (int d = 0; d < 2; ++d) {
                        const bf16x8 va = *(LAS const bf16x8*)(Vt + (32 * d + r) * VPITCH + (kvb * 32 + 16 * ss + 8 * h) * 2);
#pragma unroll
                        for (int mp = 0; mp < NM; ++mp) o[mp][d] = MFMA32(va, pb[mp], o[mp][d]);
                    }
                }
        }
        }
        if (t + 1 < nT) ATT_STAGE(buf ^ 1);
        __syncthreads();
    }
#undef ATT_STAGE
    float inv[NM];
#pragma unroll
    for (int mp = 0; mp < NM; ++mp) inv[mp] = 1.f / hswap_sum(lrun[mp]);
    float rn = 1.f;
    if (DIFF) {
        const float lam = ((const float*)(ws + WS_PAR))[PB_LAM]; float ss = 0.f;
#pragma unroll
        for (int d = 0; d < 2; ++d)
#pragma unroll
            for (int i = 0; i < 16; ++i) { const float v = o[0][d][i] * inv[0] - lam * (o[NM - 1][d][i] * inv[NM - 1]); o[0][d][i] = v; ss += v * v; }
        ss = hswap_sum(ss);
        rn = rsqrtf(ss * (1.f / 64.f) + EPS) * 0.8f;
    }
    bf16_t* orow = MIX + grow * DMODEL + (DIFF ? 0 : 512) + hd * 64;
#pragma unroll
    for (int d = 0; d < 2; ++d) {
        u32x2 pk[4];
#pragma unroll
        for (int g4 = 0; g4 < 4; ++g4) { const int d0 = 32 * d + 8 * g4 + 4 * h; f32x4 v;
            if (DIFF) { const f32x4 gw = *(const f32x4*)(subln_g + d0); v[0] = o[0][d][4 * g4] * rn * gw[0]; v[1] = o[0][d][4 * g4 + 1] * rn * gw[1]; v[2] = o[0][d][4 * g4 + 2] * rn * gw[2]; v[3] = o[0][d][4 * g4 + 3] * rn * gw[3]; }
            else { v[0] = o[0][d][4 * g4] * inv[0]; v[1] = o[0][d][4 * g4 + 1] * inv[0]; v[2] = o[0][d][4 * g4 + 2] * inv[0]; v[3] = o[0][d][4 * g4 + 3] * inv[0]; }
            pk[g4] = pk4(v); }
#pragma unroll
        for (int gp = 0; gp < 2; ++gp) {
            const auto r0 = __builtin_amdgcn_permlane32_swap(pk[2 * gp].x, pk[2 * gp + 1].x, false, false);
            const auto r1 = __builtin_amdgcn_permlane32_swap(pk[2 * gp].y, pk[2 * gp + 1].y, false, false);
            const u32x4 w = {r0[0], r1[0], r0[1], r1[1]};
            *(u32x4*)(orow + 32 * d + 8 * (2 * gp + h)) = w;
        }
    }
}

__device__ __forceinline__ void gmlp_item(LAS unsigned char* lds, unsigned char* ws, int item, int wid) {
    const int tid = mk_tid(wid), lane = tid & 63, r = lane & 31, h = lane >> 5;
    const float* pb = (const float*)(ws + WS_PAR);
    const bf16_t* GU = (const bf16_t*)(ws + WS_GU); const bf16_t* GV = (const bf16_t*)(ws + WS_GV); const float* gvst = (const float*)(ws + WS_GVST);
    const bf16_t* WSB = (const bf16_t*)(ws + WS_WSB); bf16_t* MIX = (bf16_t*)(ws + WS_MIX);
    const int ch = item >> 2, g0 = (item & 3) * 2; const size_t row0 = (size_t)ch * 128;
    constexpr int GP = 136;
    const int mb = wid & 3, grp = wid >> 2, g = g0 + grp, c = g * 64 + r;
    const int s = tid >> 2, dc = (tid & 3) * 32; const size_t frow = row0 + s;
    const bf16_t* src = GV + frow * 512 + g0 * 64 + dc;
    const u32x4 w0 = *(const u32x4*)src, w1 = *(const u32x4*)(src + 8), w2 = *(const u32x4*)(src + 16), w3 = *(const u32x4*)(src + 24);
    const float s1 = gvst[2 * frow], s2 = gvst[2 * frow + 1];
    const bf16_t* Ap = WSB + ((size_t)g * 128 + 32 * mb + r) * 128 + 8 * h;
    bf16x8 av[8];
#pragma unroll
    for (int kk = 0; kk < 8; ++kk) av[kk] = (kk < 2 * (mb + 1)) ? *(const bf16x8*)(Ap + 16 * kk) : (bf16x8){0, 0, 0, 0, 0, 0, 0, 0};
    bf16_t gu0[16], gu1[16]; float bs[16];
#pragma unroll
    for (int i = 0; i < 16; ++i) { const int t = 32 * mb + crow(i, h); const size_t row = row0 + t; gu0[i] = GU[row * 512 + c]; gu1[i] = GU[row * 512 + c + 32]; bs[i] = pb[PB_GBS + g * 128 + t]; }
    {
        const float mean = s1 * (1.f / 512.f), var = fmaxf(s2 * (1.f / 512.f) - mean * mean, 0.f), rstd = rsqrtf(var + EPS);
        const float* lg = pb + PB_GLNG + g0 * 64 + dc; const float* lb = pb + PB_GLNB + g0 * 64 + dc;
        LAS bf16_t* dst = (LAS bf16_t*)lds + dc * GP + s;
        const unsigned ww[16] = {w0.x, w0.y, w0.z, w0.w, w1.x, w1.y, w1.z, w1.w, w2.x, w2.y, w2.z, w2.w, w3.x, w3.y, w3.z, w3.w};
#pragma unroll
        for (int i = 0; i < 16; ++i) {
            const float y0 = (bflo(ww[i]) - mean) * rstd * lg[2 * i] + lb[2 * i], y1 = (bfhi(ww[i]) - mean) * rstd * lg[2 * i + 1] + lb[2 * i + 1];
            dst[(2 * i) * GP] = f2bf(y0); dst[(2 * i + 1) * GP] = f2bf(y1);
        }
    }
    __syncthreads();
    f32x16 acc0, acc1;
#pragma unroll
    for (int i = 0; i < 16; ++i) { acc0[i] = 0.f; acc1[i] = 0.f; }
    LAS const unsigned char* Bp = lds + ((grp * 64 + r) * GP + 8 * h) * 2;
#pragma unroll
    for (int kk = 0; kk < 8; ++kk)
        if (kk < 2 * (mb + 1)) { const bf16x8 b0 = *(LAS const bf16x8*)(Bp + 32 * kk), b1 = *(LAS const bf16x8*)(Bp + 32 * GP * 2 + 32 * kk);
            acc0 = MFMA32(av[kk], b0, acc0); acc1 = MFMA32(av[kk], b1, acc1); }
#pragma unroll
    for (int i = 0; i < 16; ++i) { const int t = 32 * mb + crow(i, h); const size_t row = row0 + t;
        MIX[row * DMODEL + c] = f2bf(bf2f(gu0[i]) * (acc0[i] + bs[i])); MIX[row * DMODEL + c + 32] = f2bf(bf2f(gu1[i]) * (acc1[i] + bs[i])); }
    __syncthreads();
}
__device__ __forceinline__ void conv_item(LAS unsigned char* lds, unsigned char* ws, int item, int wid) {
    const float* pb = (const float*)(ws + WS_PAR);
    const int tid = mk_tid(wid), lane = tid & 63;
    const bf16_t* CP = (const bf16_t*)(ws + WS_CP); bf16_t* MIX = (bf16_t*)(ws + WS_MIX);
    constexpr int CT = 64, HT = 32;
    const size_t row0 = (size_t)item * CT; const int half = tid >> 8, c2 = (tid & 255) * 2;
    const size_t hrow0 = row0 + half * HT; const int pos0 = (int)(hrow0 & (SEQL - 1));
    f32x2_t in[HT + 30];
#pragma unroll
    for (int i = 0; i < HT + 30; ++i) { const int p = pos0 + i - 30; unsigned w = 0u; if (p >= 0) w = *(const unsigned*)(CP + (hrow0 + i - 30) * 512 + c2); in[i] = (f32x2_t){bflo(w), bfhi(w)}; }
    f32x2_t w[31];
#pragma unroll
    for (int k = 0; k < 31; ++k) w[k] = *(const f32x2_t*)(pb + PB_CW + k * 512 + c2);
    const f32x2_t bb = *(const f32x2_t*)(pb + PB_CB + c2);
    LAS float* outl = (LAS float*)lds;
#pragma unroll
    for (int t = 0; t < HT; ++t) { f32x2_t acc = bb;
#pragma unroll
        for (int k = 0; k < 31; ++k) acc = __builtin_elementwise_fma(w[k], in[t + k], acc);
        *(LAS f32x2_t*)(outl + (half * HT + t) * 512 + c2) = acc; }
    __syncthreads();
    const f32x4 g0 = *(const f32x4*)(pb + PB_CLNG + lane * 8), g1 = *(const f32x4*)(pb + PB_CLNG + lane * 8 + 4), b0 = *(const f32x4*)(pb + PB_CLNB + lane * 8), b1 = *(const f32x4*)(pb + PB_CLNB + lane * 8 + 4);
#pragma unroll
    for (int tt = 0; tt < CT / 8; ++tt) {
        const int t = (CT / 8) * wid + tt;
        const f32x4 v0 = *(LAS const f32x4*)(outl + t * 512 + lane * 8), v1 = *(LAS const f32x4*)(outl + t * 512 + lane * 8 + 4);
        const float s1 = wave_sum(sum4(v0) + sum4(v1)), mean = s1 * (1.f / 512.f);
        const f32x4 d0 = v0 - mean, d1 = v1 - mean;
        const float s2 = wave_sum(dot4(d0) + dot4(d1)), rstd = rsqrtf(s2 * (1.f / 512.f) + EPS);
        f32x4 y0 = d0 * rstd * g0 + b0, y1 = d1 * rstd * g1 + b1;
#pragma unroll
        for (int j = 0; j < 4; ++j) { y0[j] = y0[j] * fast_sigmoid(y0[j]); y1[j] = y1[j] * fast_sigmoid(y1[j]); }
        u32x4 o; o.x = cvtpk(y0[0], y0[1]); o.y = cvtpk(y0[2], y0[3]); o.z = cvtpk(y1[0], y1[1]); o.w = cvtpk(y1[2], y1[3]);
        *(u32x4*)(MIX + (row0 + t) * DMODEL + 512 + lane * 8) = o;
    }
    __syncthreads();
}

#define XB_TMO      128
#define XB_XCNT(j)  (256  + 64 * (j))
#define XB_XSUB(j)  (1280 + 64 * (j))
#define XB_XGEN(j)  (2304 + 64 * (j))
#define XB_TOP      3328
#define XB_TOPGEN   3392
#define XCD_BAR_WORDS 3456
#define XB_SPIN_CAP (1u << 18)

__device__ __forceinline__ unsigned xb_ld(unsigned* p)              { return __hip_atomic_load(p, __ATOMIC_RELAXED, __HIP_MEMORY_SCOPE_AGENT); }
__device__ __forceinline__ unsigned xb_add(unsigned* p, unsigned v) { return __hip_atomic_fetch_add(p, v, __ATOMIC_RELAXED, __HIP_MEMORY_SCOPE_AGENT); }
__device__ __forceinline__ unsigned xb_xcc_id() { return (unsigned)__builtin_amdgcn_s_getreg((3 << 11) | 20) & 0xFu; }
#define XB_SPIN(cond, bar) do { unsigned _sp = 0; while (cond) { __builtin_amdgcn_s_sleep(1); \
    if ((++_sp & 255u) == 0u) { if (xb_ld(&(bar)[XB_TMO])) break; if (_sp > XB_SPIN_CAP) { atomicAdd(&(bar)[XB_TMO], 1u); break; } } } } while (0)

struct XcdBarrier {
    unsigned* bar; unsigned x;
    volatile LAS unsigned* st;
};

__device__ __forceinline__ XcdBarrier xcd_barrier_post(unsigned* bar, volatile LAS unsigned* st) {
    XcdBarrier b; b.bar = bar; b.x = xb_xcc_id(); b.st = st;
    if (threadIdx.x == 0) (void)xb_add(&bar[XB_XCNT(b.x)], 1u);
    return b;
}
__device__ __forceinline__ void xcd_barrier_complete(unsigned* bar, unsigned x, unsigned& nloc, unsigned& nx) {
    const unsigned G = gridDim.x * gridDim.y * gridDim.z;
    unsigned sum, cnt, mine, sp = 0u;
    for (;;) {
        sum = 0u; cnt = 0u; mine = 0u;
#pragma unroll
        for (unsigned j = 0; j < 16; ++j) { const unsigned c = xb_ld(&bar[XB_XCNT(j)]); sum += c; cnt += (c > 0u) ? 1u : 0u; mine = (j == x) ? c : mine; }
        if (sum == G) break;
        __builtin_amdgcn_s_sleep(1);
        if ((++sp & 255u) == 0u) { if (xb_ld(&bar[XB_TMO])) break; if (sp > XB_SPIN_CAP) { atomicAdd(&bar[XB_TMO], 1u); break; } }
    }
    nloc = mine > 0u ? mine : 1u; nx = cnt > 0u ? cnt : 1u;
}

__device__ __forceinline__ void xcd_barrier(const XcdBarrier& b) {
    asm volatile("s_waitcnt vmcnt(0)" ::: "memory");
    __syncthreads();
    if (threadIdx.x == 0) {
        unsigned* bar = b.bar;
        __builtin_amdgcn_s_waitcnt(0);
        unsigned nloc = b.st[0], nx = b.st[1];
        if (nloc == 0u) { xcd_barrier_complete(bar, b.x, nloc, nx); b.st[0] = nloc; b.st[1] = nx; }
        const unsigned old = xb_add(&bar[XB_XSUB(b.x)], 1u);
        const unsigned gen = old / nloc;
        if (old + 1u == (gen + 1u) * nloc) {
            __builtin_amdgcn_fence(__ATOMIC_RELEASE, "agent");
            asm volatile("s_waitcnt vmcnt(0)" ::: "memory");
            const unsigned og = xb_add(&bar[XB_TOP], 1u);
            const unsigned tg = og / nx;
            if (og + 1u == (tg + 1u) * nx) xb_add(&bar[XB_TOPGEN], 1u);
            else XB_SPIN(xb_ld(&bar[XB_TOPGEN]) == tg, bar);
            __builtin_amdgcn_fence(__ATOMIC_ACQUIRE, "agent");
            xb_add(&bar[XB_XGEN(b.x)], 1u);
            asm volatile("s_waitcnt vmcnt(0)" ::: "memory");
        } else {
            XB_SPIN(xb_ld(&bar[XB_XGEN(b.x)]) == gen, bar);
            __builtin_amdgcn_fence(__ATOMIC_ACQUIRE, "agent");
            asm volatile("s_waitcnt vmcnt(0)" ::: "memory");
        }
    }
    __syncthreads();
}

#define WSP(var) __attribute__((address_space(1))) unsigned char* var##_g = (__attribute__((address_space(1))) unsigned char*)a.ws; asm volatile("" : "+s"(var##_g)); unsigned char* var = (unsigned char*)var##_g
template <int LAYER> __device__ __forceinline__ void tail_phases(const Args& a, LAS unsigned char* lds, const XcdBarrier& bar, int G, int bx, int wid) {
    {
        WSP(ws);
        pg8::Gemm g{(const bf16_t*)(ws + WS_MIX), (const bf16_t*)(ws + (LAYER == 0 ? WS_WEO : WS_WOO)), MTOK, 1024, 1024}; pg8::StaticOrder S; S.init(MTOK, 1024, G, bx);
        EpiResid E{(const bf16_t*)(ws + WS_XB), nullptr, (bf16_t*)(ws + WS_XB), (float*)(ws + WS_SSQ) + (LAYER == 0 ? 1 : 3) * MTOK};
#ifndef NO_GR
        pg8::gemm_phase<EpiResid, pg8::StaticOrder, true, true>(lds, g, S, E, wid);
#endif
    }
    xcd_barrier(bar);
    {
        WSP(ws);
        pg8::Gemm g{(const bf16_t*)(ws + WS_XB), (const bf16_t*)(ws + (LAYER == 0 ? WS_WFI0 : WS_WFI1)), MTOK, 2 * DFF, 1024}; pg8::StaticOrder S; S.init(MTOK, 2 * DFF, G, bx);
        EpiSwiglu E{(const float*)(ws + WS_SSQ) + (LAYER == 0 ? 1 : 3) * MTOK, (bf16_t*)(ws + WS_ACT)};
#ifndef NO_GS
        pg8::gemm_phase<EpiSwiglu, pg8::StaticOrder, true, true>(lds, g, S, E, wid);
#endif
        if (LAYER == 0) { const int n6 = (MTOK / 256) * (2 * DFF / 256) - 5 * G;
            if (G == 256 && bx >= n6) convert_late(a, ws, lds, (bx - n6) * 8 + wid, (G - n6) * 8, wid);
            else if (G != 256 && bx == 0) convert_late(a, ws, lds, wid, 8, wid); }
    }
    xcd_barrier(bar);
    {
        WSP(ws);
        pg8::Gemm g{(const bf16_t*)(ws + WS_ACT), (const bf16_t*)(ws + (LAYER == 0 ? WS_WFO0 : WS_WFO1)), MTOK, 1024, DFF}; pg8::StaticOrder S; S.init(MTOK, 1024, G, bx);
        EpiResid E{(const bf16_t*)(ws + WS_XB), LAYER == 0 ? nullptr : a.out, LAYER == 0 ? (bf16_t*)(ws + WS_XB) : nullptr, LAYER == 0 ? (float*)(ws + WS_SSQ) + 2 * MTOK : nullptr};
#ifndef NO_GR
        pg8::gemm_phase<EpiResid, pg8::StaticOrder, true, true>(lds, g, S, E, wid);
#endif
    }
}

__global__ void __launch_bounds__(512, 2) mega_fwd(Args a) {
    extern __shared__ __attribute__((aligned(16))) unsigned char smem[];
    LAS unsigned char* lds = (LAS unsigned char*)smem;
    const int G = gridDim.x, bx = blockIdx.x, wid = __builtin_amdgcn_readfirstlane(threadIdx.x >> 6);
#define VCU ((G % 8 == 0) ? (bx % 8) * (G / 8) + bx / 8 : bx)
    if (threadIdx.x < 2) ((volatile LAS unsigned*)(lds + LDS_BYTES - 64))[threadIdx.x] = 0u;
    __syncthreads();
    const XcdBarrier bar = xcd_barrier_post((unsigned*)(a.ws + WS_BAR), (volatile LAS unsigned*)(lds + LDS_BYTES - 64));
#ifndef NO_PRO
    prologue(a, lds, VCU, G, wid);
#endif
    xcd_barrier(bar);
    {
        WSP(ws);
        pg8::Gemm g{(const bf16_t*)(ws + WS_XB), (const bf16_t*)(ws + WS_WEI), MTOK, 1024, 1024}; pg8::StaticOrder S; S.init(MTOK, 1024, G, bx); EpiDiffQK E{ws};
#ifndef NO_GEI
        pg8::gemm_phase<EpiDiffQK, pg8::StaticOrder, true, true>(lds, g, S, E, wid);
#endif
    }
    {
        WSP(ws);
        pg8::Gemm g{(const bf16_t*)(ws + WS_XB), (const bf16_t*)(ws + WS_WEI) + (size_t)1024 * 1024, MTOK, 1024, 1024}; pg8::StaticOrder S; S.init(MTOK, 1024, G, bx); EpiMobaQK E{ws};
#ifndef NO_GEI
        pg8::gemm_phase<EpiMobaQK, pg8::StaticOrder, true, true>(lds, g, S, E, wid);
#endif
    }
    {
        WSP(ws);
        pg8::Gemm g{(const bf16_t*)(ws + WS_XB), (const bf16_t*)(ws + WS_WEI) + (size_t)2048 * 1024, MTOK, 1024, 1024}; pg8::StaticOrder S; S.init(MTOK, 1024, G, bx); EpiV E{ws};
#ifndef NO_GEI
        pg8::gemm_phase<EpiV, pg8::StaticOrder, false, true>(lds, g, S, E, wid);
#endif
    }
    xcd_barrier(bar);
    {
        WSP(ws);
        for (int u = VCU; u < 256; u += G) {
            const int bh = u >> 3, s = u & 7, b = bh >> 3, hd = bh & 7;
#ifndef NO_AD
#pragma nounroll
            for (int k = 0; k < 2; ++k) attn_unit<true>(lds, ws, b, hd, k == 0 ? 15 - s : s, wid);
#endif
#ifndef NO_AM
#pragma nounroll
            for (int k = 0; k < 2; ++k) attn_unit<false>(lds, ws, b, hd, k == 0 ? 15 - s : s, wid);
#endif
        }
    }
    xcd_barrier(bar);
    tail_phases<0>(a, lds, bar, G, bx, wid);
    xcd_barrier(bar);
    {
        WSP(ws);
        pg8::Gemm g{(const bf16_t*)(ws + WS_XB), (const bf16_t*)(ws + WS_WOI), MTOK, 2048, 1024}; pg8::StaticOrder S; S.init(MTOK, 2048, G, bx); EpiOddIn E{ws};
#ifndef NO_GOI
        pg8::gemm_phase<EpiOddIn, pg8::StaticOrder, true, true>(lds, g, S, E, wid);
#endif
    }
    xcd_barrier(bar);
    {
        WSP(ws);
        for (int it = bx; it < 256 + 512; it += G) {
#ifndef NO_GM
            if (it >= 256) gmlp_item(lds, ws, it - 256, wid);
#endif
#ifndef NO_CV
            if (it < 256) conv_item(lds, ws, it, wid);
#endif
        }
    }
    xcd_barrier(bar);
    tail_phases<1>(a, lds, bar, G, bx, wid);
}

extern "C" void kernel_launch(void* const* d_in, const int* in_sizes, int n_in, void* d_out, int out_size, void* d_ws, size_t ws_size, hipStream_t stream) {
    static int grid = 0;
    if (grid == 0) {
        if (n_in != 27 || out_size != MTOK * DMODEL || ws_size < WS_END) { fprintf(stderr, "kernel_launch: unexpected shapes (n_in %d out %d ws %zu)\n", n_in, out_size, ws_size); grid = -1; return; }
        int dev = 0, cus = 0, per_cu = 0;
        hipGetDevice(&dev); hipDeviceGetAttribute(&cus, hipDeviceAttributeMultiprocessorCount, dev);
        hipFuncSetAttribute((const void*)mega_fwd, hipFuncAttributeMaxDynamicSharedMemorySize, LDS_BYTES);
        hipOccupancyMaxActiveBlocksPerMultiprocessor(&per_cu, (const void*)mega_fwd, 512, LDS_BYTES);
        if (per_cu < 1) { fprintf(stderr, "kernel_launch: occupancy query says %d blocks/CU\n", per_cu); per_cu = 1; }
        (void)hipGetLastError();
        grid = cus;
    }
    if (grid < 0) return;
    if (hipMemsetAsync((char*)d_ws + WS_BAR, 0, 3456 * 4, stream) != hipSuccess) { fprintf(stderr, "kernel_launch: memset of the barrier words failed\n"); return; }
    Args a{};
    for (int i = 0; i < 27; ++i) a.in[i] = (const float*)d_in[i];
    a.out = (float*)d_out; a.ws = (unsigned char*)d_ws;
    void* args[] = {&a};
    hipError_t e = hipLaunchCooperativeKernel((const void*)mega_fwd, dim3(grid), dim3(512), args, LDS_BYTES, stream);
    if (e != hipSuccess) fprintf(stderr, "cooperative launch failed: %s (grid %d)\n", hipGetErrorString(e), grid);
}
```

```cpp
#include <hip/hip_runtime.h>
#include <hip/hip_cooperative_groups.h>
#include <hip/hip_bf16.h>
#include <cstdio>
#include <cstdint>
namespace cg = cooperative_groups;
namespace pg8 {
#define PG8_LAS __attribute__((address_space(3)))
typedef unsigned short bf16_t;
typedef short bf16x8 __attribute__((ext_vector_type(8)));
typedef float f32x4 __attribute__((ext_vector_type(4)));
typedef unsigned u32x4 __attribute__((ext_vector_type(4)));
constexpr int BM = 256, BK = 64, HALF = 128, HTB = HALF * BK * 2  , STAGE_BYTES = 8 * HTB, NXCD = 8, WGM = 8;

__host__ __device__ __forceinline__ int lds_byte(int r, int c) { const int st = (r >> 4) * 2 + (c >> 5), rr = r & 15, cc = c & 31, ob = rr * 64 + cc * 2; return st * 1024 + (ob ^ (((ob >> 9) & 1) << 5)); }
__host__ __device__ __forceinline__ void stage_rc(int b, int& R, int& C) { const int st = b / 1024, sb = b % 1024, swz = sb ^ (((sb >> 9) & 1) << 5); R = (st >> 1) * 16 + swz / 64; C = (st & 1) * 32 + (swz % 64) / 2; }
__host__ __device__ __forceinline__ int perm32(int rho) { const int n = rho >> 4, i = rho & 15; return 8 * (i >> 2) + 4 * n + (i & 3); }

struct Unit { int pm, pn; };
struct Gemm { const bf16_t* A; const bf16_t* Bt; int M, N, K; };

struct StaticOrder {
    int nM, nN, nwg, G, c;
    __host__ __device__ void init(int M, int N, int G_, int c_) { nM = M / BM; nN = N / BM; nwg = nM * nN; G = G_; c = c_; }
    __host__ __device__ bool next(int i, Unit& u) const {
        const long L = (long)i * G + c; if (L >= nwg) return false;
        int wgid = (int)L; { const int q = nwg / NXCD, r = nwg % NXCD, xcd = wgid % NXCD, off = wgid / NXCD; wgid = (xcd < r ? xcd * (q + 1) : r * (q + 1) + (xcd - r) * q) + off; }
        const int nig = WGM * nN, gid = wgid / nig, fm = gid * WGM, gsz = (nM - fm) < WGM ? (nM - fm) : WGM;
        u.pm = fm + ((wgid % nig) % gsz); u.pn = (wgid % nig) / gsz; return true;
    }
    __device__ __forceinline__ void a_ready(const Unit&) const {}
    __device__ __forceinline__ void done(const Unit&) const {}
};

__device__ __forceinline__ unsigned cvt_pk_bf16(float lo, float hi) { unsigned r; asm volatile("v_cvt_pk_bf16_f32 %0, %1, %2" : "=v"(r) : "v"(lo), "v"(hi)); return r; }
typedef float f32x2 __attribute__((ext_vector_type(2)));
__device__ __forceinline__ f32x2 gelu_pk(f32x2 v) {
    const f32x2 av = __builtin_elementwise_abs(v), d = av * 0.2316418882f + 1.0f;
    f32x2 t; t.x = __builtin_amdgcn_rcpf(d.x); t.y = __builtin_amdgcn_rcpf(d.y);
    f32x2 q = t * 0.5307027145f + (-0.7265760135f); q = q * t + 0.7107068705f; q = q * t + (-0.142248368f); q = q * t + 0.127414796f; q = q * t;
    const f32x2 s = (v * v) * (-0.72134752044f);
    f32x2 e; e.x = __builtin_amdgcn_exp2f(s.x); e.y = __builtin_amdgcn_exp2f(s.y);
    const f32x2 m = v * (q * e), r = v - m;
    f32x2 o; o.x = v.x < 0.f ? m.x : r.x; o.y = v.y < 0.f ? m.y : r.y; return o;
}

template <int ACT  > struct EpiBf16 {
    static constexpr bool PERM = true, AFTER_DRAIN = false; static_assert(ACT == 0 || ACT == 1, "EpiBf16: ACT is 0 (none) or 1 (gelu_pk)");
    bf16_t* O; int ldc; const float* bias; int split_cols; size_t split_stride; float scale0;
    __device__ __forceinline__ void operator()(const f32x4 (&acc)[2][2][4][2], const Unit& u, int wr, int wc, int fr, int fq) const {
        const int row0 = u.pm * BM + wr * 64 + fr; int colt = u.pn * BM; bf16_t* base = O;
        float sc = 1.f; if (split_cols) { const int t = colt / split_cols; base += (size_t)t * split_stride; colt -= t * split_cols; if (t == 0) sc = scale0; }
        const int col0 = colt + wc * 32 + 8 * fq, bcol0 = u.pn * BM + wc * 32 + 8 * fq;
        f32x4 bv[2][2];
#pragma unroll
        for (int bj = 0; bj < 2; ++bj)
#pragma unroll
            for (int n = 0; n < 2; ++n) bv[bj][n] = bias ? *(const f32x4*)(bias + bcol0 + bj * HALF + 4 * n) : (f32x4){0.f, 0.f, 0.f, 0.f};
#pragma unroll
        for (int ai = 0; ai < 2; ++ai)
#pragma unroll
            for (int m = 0; m < 4; ++m) { bf16_t* rowp = base + (size_t)(row0 + ai * HALF + m * 16) * ldc + col0;
#pragma unroll
                for (int bj = 0; bj < 2; ++bj) { f32x4 v0 = acc[ai][bj][m][0] + bv[bj][0], v1 = acc[ai][bj][m][1] + bv[bj][1];
                    if (ACT == 1) { f32x2 a = gelu_pk((f32x2){v0[0], v0[1]}), b = gelu_pk((f32x2){v0[2], v0[3]}), c = gelu_pk((f32x2){v1[0], v1[1]}), d = gelu_pk((f32x2){v1[2], v1[3]});
                        v0 = (f32x4){a.x, a.y, b.x, b.y}; v1 = (f32x4){c.x, c.y, d.x, d.y}; }
                    v0 = v0 * sc; v1 = v1 * sc; u32x4 w; w.x = cvt_pk_bf16(v0[0], v0[1]); w.y = cvt_pk_bf16(v0[2], v0[3]); w.z = cvt_pk_bf16(v1[0], v1[1]); w.w = cvt_pk_bf16(v1[2], v1[3]);
                    *(u32x4*)(rowp + bj * HALF) = w; } }
    }
};

struct PanelStats {
    unsigned* xbuf;
    unsigned* cnt;
    unsigned* tmo;
    int ntn; float eps;
    unsigned code;
    __device__ __forceinline__ bool run(const f32x4 (&v)[2][2][4][2], const Unit& u, int wr, int wc, int fr, int fq, PG8_LAS unsigned char* lds, int wid, int lane) const {
        typedef float f32x2v __attribute__((ext_vector_type(2)));
        PG8_LAS f32x2v* P = (PG8_LAS f32x2v*)lds;
        PG8_LAS f32x2v* S = (PG8_LAS f32x2v*)(lds + 8192);
        PG8_LAS unsigned* flag = (PG8_LAS unsigned*)(lds + 8192 + 2048);
#pragma unroll
        for (int ai = 0; ai < 2; ++ai)
#pragma unroll
            for (int m = 0; m < 4; ++m) {
                float s = 0.f;
#pragma unroll
                for (int bj = 0; bj < 2; ++bj)
#pragma unroll
                    for (int n = 0; n < 2; ++n) { const f32x4 x = v[ai][bj][m][n]; s += (x[0] + x[1]) + (x[2] + x[3]); }
                s += __shfl_xor(s, 16); s += __shfl_xor(s, 32);
                const float mw = s * (1.0f / 64.0f); float q = 0.f;
#pragma unroll
                for (int bj = 0; bj < 2; ++bj)
#pragma unroll
                    for (int n = 0; n < 2; ++n) { const f32x4 d = v[ai][bj][m][n] - mw; q += (d[0] * d[0] + d[1] * d[1]) + (d[2] * d[2] + d[3] * d[3]); }
                q += __shfl_xor(q, 16); q += __shfl_xor(q, 32);
                if (fq == 0) P[(ai * HALF + wr * 64 + m * 16 + fr) * 4 + wc] = (f32x2v){mw, q};
            }
        asm volatile("s_waitcnt lgkmcnt(0)" ::: "memory"); __builtin_amdgcn_s_barrier(); asm volatile("" ::: "memory");
#if defined(BROKEN_EXCHANGE_NO_WAIT)
#warning BROKEN CONTROL BUILD: the row-statistics exchange does not wait; results are wrong by design
        if (blockIdx.x >= 64) { const long long t0_ = clock64(); while (clock64() - t0_ < 60000) __builtin_amdgcn_s_sleep(8); }
#endif
        const int row = wid * 32 + (lane & 31);
        if (lane < 32) {
            const f32x2v a = P[row * 4 + 0], b = P[row * 4 + 1], c = P[row * 4 + 2], d = P[row * 4 + 3];
            const float mt = (a.x + b.x + c.x + d.x) * 0.25f;
            const float da = a.x - mt, db = b.x - mt, dc = c.x - mt, dd = d.x - mt;
            const float m2 = (a.y + b.y) + (c.y + d.y) + 64.0f * ((da * da + db * db) + (dc * dc + dd * dd));
            unsigned long long* slot = (unsigned long long*)xbuf + ((size_t)(u.pm * BM + row) * 4 + u.pn);
            __hip_atomic_store(slot, ((unsigned long long)__float_as_uint(m2) << 32) | __float_as_uint(mt), __ATOMIC_RELAXED, __HIP_MEMORY_SCOPE_AGENT);
        }
        asm volatile("s_waitcnt vmcnt(0)" ::: "memory");
        if (lane == 0) __hip_atomic_fetch_add(cnt + 64 * u.pm, 1u, __ATOMIC_RELAXED, __HIP_MEMORY_SCOPE_AGENT);
        if (wid == 0) {
            bool dead = false; const unsigned long long t0 = __builtin_amdgcn_s_memrealtime(); const unsigned want = 8u * (unsigned)ntn;
            for (;;) {
#if defined(BROKEN_EXCHANGE_NO_WAIT)
                break;
#endif
                if ((unsigned)__builtin_amdgcn_readfirstlane(__hip_atomic_load(cnt + 64 * u.pm, __ATOMIC_RELAXED, __HIP_MEMORY_SCOPE_AGENT)) >= want) break;
                if (__builtin_amdgcn_s_memrealtime() - t0 > 2000000ull) {
                    if (lane == 0) { unsigned expect = 0u; __hip_atomic_compare_exchange_strong(tmo + 1, &expect, code | (unsigned)(u.pm & 0xff), __ATOMIC_RELAXED, __ATOMIC_RELAXED, __HIP_MEMORY_SCOPE_AGENT);
                                     __hip_atomic_store(tmo, 1u, __ATOMIC_RELAXED, __HIP_MEMORY_SCOPE_AGENT); }
                    dead = true; break; }
                __builtin_amdgcn_s_sleep(2);
            }
            __builtin_amdgcn_fence(__ATOMIC_ACQUIRE, "agent");
            if (lane == 0) flag[0] = dead ? 1u : 0u;
        }
        asm volatile("s_waitcnt vmcnt(0) lgkmcnt(0)" ::: "memory"); __builtin_amdgcn_s_barrier(); asm volatile("" ::: "memory");
        const bool bad = flag[0] != 0u;
        if (lane < 32) {
            const unsigned long long* slot = (const unsigned long long*)xbuf + (size_t)(u.pm * BM + row) * 4; float mt[4], m2[4]; float ms = 0.f;
#pragma unroll
            for (int t = 0; t < 4; ++t) { if (t < ntn) { const unsigned long long w = __hip_atomic_load(slot + t, __ATOMIC_RELAXED, __HIP_MEMORY_SCOPE_AGENT); mt[t] = __uint_as_float((unsigned)w); m2[t] = __uint_as_float((unsigned)(w >> 32)); } else { mt[t] = 0.f; m2[t] = 0.f; } ms += mt[t]; }
            const float mean = ms / (float)ntn; float q = 0.f;
#pragma unroll
            for (int t = 0; t < 4; ++t) if (t < ntn) { const float dm = mt[t] - mean; q += m2[t] + 256.0f * dm * dm; }
            S[row] = (f32x2v){mean, 1.0f / sqrtf(q / (256.0f * (float)ntn) + eps)};
        }
        asm volatile("s_waitcnt lgkmcnt(0)" ::: "memory"); __builtin_amdgcn_s_barrier(); asm volatile("" ::: "memory");
        return bad;
    }
};
struct EpiLnRes {
    static constexpr bool PERM = false, AFTER_DRAIN = true;
    const float* base; float* out; int ldc; const float* bias; PanelStats st; unsigned poison;
    __device__ __forceinline__ void fused(f32x4 (&acc)[2][2][4][2], const Unit& u, int wr, int wc, int fr, int fq, PG8_LAS unsigned char* lds, int wid, int lane) const {
        typedef float f32x2v __attribute__((ext_vector_type(2)));
        const PG8_LAS f32x2v* S = (const PG8_LAS f32x2v*)(lds + 8192);
        const int col0 = u.pn * BM + wc * 32 + 4 * fq;
#pragma unroll
        for (int bj = 0; bj < 2; ++bj)
#pragma unroll
            for (int n = 0; n < 2; ++n) { const f32x4 bv = bias ? *(const f32x4*)(bias + col0 + bj * HALF + n * 16) : (f32x4){0.f, 0.f, 0.f, 0.f};
#pragma unroll
                for (int ai = 0; ai < 2; ++ai)
#pragma unroll
                    for (int m = 0; m < 4; ++m) acc[ai][bj][m][n] += bv; }
        f32x4 pre[4][2][2];
#pragma unroll
        for (int m = 0; m < 4; ++m) { const size_t off = (size_t)(u.pm * BM + wr * 64 + m * 16 + fr) * ldc + col0;
#pragma unroll
            for (int bj = 0; bj < 2; ++bj)
#pragma unroll
                for (int n = 0; n < 2; ++n) pre[m][bj][n] = *(const f32x4*)(base + off + bj * HALF + n * 16); }
        const bool bad = st.run(acc, u, wr, wc, fr, fq, lds, wid, lane) || poison != 0u;
        const float qnan = __builtin_nanf("");
#pragma unroll
        for (int ai = 0; ai < 2; ++ai)
#pragma unroll
            for (int m = 0; m < 4; ++m) { const int r = ai * HALF + wr * 64 + m * 16 + fr; const f32x2v sr = S[r]; const size_t off = (size_t)(u.pm * BM + r) * ldc + col0;
#pragma unroll
                for (int bj = 0; bj < 2; ++bj)
#pragma unroll
                    for (int n = 0; n < 2; ++n) { const f32x4 bs = ai == 0 ? pre[m][bj][n] : *(const f32x4*)(base + off + bj * HALF + n * 16); f32x4 o = bs + (acc[ai][bj][m][n] - sr.x) * sr.y;
                        if (bad) o = (f32x4){qnan, qnan, qnan, qnan}; *(f32x4*)(out + off + bj * HALF + n * 16) = o; }
                if (m & 1) asm volatile("" ::: "memory"); }
    }
};
struct EpiLnResLn {
    static constexpr bool PERM = false, AFTER_DRAIN = true;
    const float* base; float* out; bf16_t* xn; int ldc; const float* bias; PanelStats st1, st2; unsigned poison;
    __device__ __forceinline__ void fused(f32x4 (&acc)[2][2][4][2], const Unit& u, int wr, int wc, int fr, int fq, PG8_LAS unsigned char* lds, int wid, int lane) const {
        typedef float f32x2v __attribute__((ext_vector_type(2))); typedef unsigned u32x2v __attribute__((ext_vector_type(2)));
        const PG8_LAS f32x2v* S = (const PG8_LAS f32x2v*)(lds + 8192);
        const int col0 = u.pn * BM + wc * 32 + 4 * fq;
#pragma unroll
        for (int bj = 0; bj < 2; ++bj)
#pragma unroll
            for (int n = 0; n < 2; ++n) { const f32x4 bv = bias ? *(const f32x4*)(bias + col0 + bj * HALF + n * 16) : (f32x4){0.f, 0.f, 0.f, 0.f};
#pragma unroll
                for (int ai = 0; ai < 2; ++ai)
#pragma unroll
                    for (int m = 0; m < 4; ++m) acc[ai][bj][m][n] += bv; }
        bool bad = st1.run(acc, u, wr, wc, fr, fq, lds, wid, lane) || poison != 0u;
        const float qnan = __builtin_nanf("");
#pragma unroll
        for (int ai = 0; ai < 2; ++ai)
#pragma unroll
            for (int m = 0; m < 4; ++m) { const int r = ai * HALF + wr * 64 + m * 16 + fr; const f32x2v sr = S[r]; const size_t off = (size_t)(u.pm * BM + r) * ldc + col0;
#pragma unroll
                for (int bj = 0; bj < 2; ++bj)
#pragma unroll
                    for (int n = 0; n < 2; ++n) { const f32x4 bs = *(const f32x4*)(base + off + bj * HALF + n * 16); acc[ai][bj][m][n] = bs + (acc[ai][bj][m][n] - sr.x) * sr.y; }
                asm volatile("" : "+v"(acc[ai][0][m][0]), "+v"(acc[ai][0][m][1]), "+v"(acc[ai][1][m][0]), "+v"(acc[ai][1][m][1]));
                if (m & 1) asm volatile("" ::: "memory"); }
        const bool bad1 = bad;
        bad = st2.run(acc, u, wr, wc, fr, fq, lds, wid, lane) || bad;
#pragma unroll
        for (int ai = 0; ai < 2; ++ai)
#pragma unroll
            for (int m = 0; m < 4; ++m) { const int r = ai * HALF + wr * 64 + m * 16 + fr; const f32x2v sr = S[r]; const size_t off = (size_t)(u.pm * BM + r) * ldc + col0;
#pragma unroll
                for (int bj = 0; bj < 2; ++bj)
#pragma unroll
                    for (int n = 0; n < 2; ++n) { const f32x4 x1 = acc[ai][bj][m][n]; *(f32x4*)(out + off + bj * HALF + n * 16) = bad1 ? (f32x4){qnan, qnan, qnan, qnan} : x1;
                        const f32x4 o = (x1 - sr.x) * sr.y; u32x2v w; w.x = cvt_pk_bf16(o[0], o[1]); w.y = cvt_pk_bf16(o[2], o[3]);
                        if (bad) { w.x = 0x7fc07fc0u; w.y = 0x7fc07fc0u; } *(u32x2v*)(xn + off + bj * HALF + n * 16) = w; }
                asm volatile("" ::: "memory"); }
    }
};

template <class Epi, class Sched, bool ALIGN_EPI = false, bool SP2 = false>
__device__ __forceinline__ void gemm_phase(PG8_LAS unsigned char* lds, const Gemm g, const Sched& S, const Epi& E, int wid_s) {
    int lane_; asm volatile("v_mbcnt_lo_u32_b32 %0, -1, 0\n\tv_mbcnt_hi_u32_b32 %0, -1, %0" : "=v"(lane_));
    const int tid = wid_s * 64 + lane_, wid = wid_s, lane = tid & 63, wr = wid >> 2, wc = wid & 3, fr = lane & 15, fq = lane >> 4;
    const int K = g.K, nt = K / BK;
    unsigned voffA[2], voffB[2];
#pragma unroll
    for (int i = 0; i < 2; ++i) { int R, C; stage_rc(tid * 16 + i * 8192, R, C); const int Rb = Epi::PERM ? ((R & ~31) + perm32(R & 31)) : R;
        voffA[i] = (unsigned)(R * K + C) * 2u; voffB[i] = (unsigned)(Rb * K + C) * 2u; }
    const size_t kstep = (size_t)(BK * 2);
    const size_t hstep = (size_t)HALF * K * 2;
    const size_t tstep = 2 * hstep;
    const unsigned ldsw = (unsigned)wid * 1024u;
    const int aoff = lds_byte(wr * 64 + fr, fq * 8), boff = lds_byte(wc * 32 + fr, fq * 8);
#define PG8_SA(b, h) (((b) * 2 + (h)) * HTB)
#define PG8_SB(b, h) ((4 + (b) * 2 + (h)) * HTB)
#define PG8_STAGE(bufoff, gbase, voff) do { _Pragma("unroll") for (int _i = 0; _i < 2; ++_i) \
        __builtin_amdgcn_global_load_lds((const unsigned*)((const char*)(gbase) + (voff)[_i]), (PG8_LAS unsigned*)(lds + (bufoff) + ldsw + _i * 8192), 16, 0, 0); } while (0)
#define PG8_LDA(dst, b, h) do { _Pragma("unroll") for (int m = 0; m < 4; ++m) _Pragma("unroll") for (int k = 0; k < 2; ++k) dst[m][k] = *(const PG8_LAS bf16x8*)(lds + PG8_SA(b, h) + aoff + m * 2048 + k * 1024); } while (0)
#define PG8_LDB(dst, b, h) do { _Pragma("unroll") for (int n = 0; n < 2; ++n) _Pragma("unroll") for (int k = 0; k < 2; ++k) dst[n][k] = *(const PG8_LAS bf16x8*)(lds + PG8_SB(b, h) + boff + n * 2048 + k * 1024); } while (0)
#define PG8_MMA(ai, bj, At, Bt) do { __builtin_amdgcn_s_setprio(1); _Pragma("unroll") for (int m = 0; m < 4; ++m) _Pragma("unroll") for (int n = 0; n < 2; ++n) _Pragma("unroll") for (int k = 0; k < 2; ++k) \
        acc[ai][bj][m][n] = __builtin_amdgcn_mfma_f32_16x16x32_bf16(Bt[n][k], At[m][k], acc[ai][bj][m][n], 0, 0, 0); __builtin_amdgcn_s_setprio(0); } while (0)
#define PG8_WAIT_V(n) asm volatile("s_waitcnt vmcnt(" #n ")" ::: "memory")
#define PG8_WAIT_L(n) asm volatile("s_waitcnt lgkmcnt(" #n ")" ::: "memory")
#define PG8_BAR __builtin_amdgcn_s_barrier()
#define PG8_SCHED __builtin_amdgcn_sched_barrier(0)
    Unit cur, nxt; int ui = 0;
    if (!S.next(0, cur)) return;
    f32x4 acc[2][2][4][2];
#pragma unroll
    for (int a = 0; a < 2; ++a)
#pragma unroll
        for (int b = 0; b < 2; ++b)
#pragma unroll
            for (int m = 0; m < 4; ++m)
#pragma unroll
                for (int n = 0; n < 2; ++n) acc[a][b][m][n] = (f32x4){0.f, 0.f, 0.f, 0.f};
    bf16x8 At[4][2], B0[2][2], B1[2][2];
    const char* cA = (const char*)g.A + (size_t)cur.pm * tstep; const char* cB = (const char*)g.Bt + (size_t)cur.pn * tstep;
    S.a_ready(cur);
    if constexpr (SP2) {
        PG8_STAGE(PG8_SB(0, 0), cB, voffB); PG8_STAGE(PG8_SB(0, 1), cB + hstep, voffB); PG8_STAGE(PG8_SA(0, 0), cA, voffA); PG8_STAGE(PG8_SA(0, 1), cA + hstep, voffA);
        if (wr == 1) PG8_BAR;
        PG8_WAIT_V(2); PG8_BAR;
        PG8_STAGE(PG8_SB(1, 0), cB + kstep, voffB); PG8_STAGE(PG8_SA(1, 0), cA + kstep, voffA); PG8_STAGE(PG8_SB(1, 1), cB + hstep + kstep, voffB);
        PG8_WAIT_V(6); PG8_BAR;
    } else {
        PG8_STAGE(PG8_SB(0, 0), cB, voffB); PG8_STAGE(PG8_SA(0, 0), cA, voffA); PG8_STAGE(PG8_SB(0, 1), cB + hstep, voffB); PG8_STAGE(PG8_SA(0, 1), cA + hstep, voffA);
        if (wr == 1) PG8_BAR;
        PG8_WAIT_V(4); PG8_BAR;
        PG8_STAGE(PG8_SB(1, 0), cB + kstep, voffB); PG8_STAGE(PG8_SA(1, 0), cA + kstep, voffA); PG8_STAGE(PG8_SB(1, 1), cB + hstep + kstep, voffB);
        PG8_WAIT_V(6); PG8_BAR;
    }
    for (;;) {
        const bool has_next = S.next(ui + 1, nxt);
        const char* nA = has_next ? (const char*)g.A + (size_t)nxt.pm * tstep : cA; const char* nB = has_next ? (const char*)g.Bt + (size_t)nxt.pn * tstep : cB;
        for (int t = 0; t < nt; t += 2) {
            const bool last = (t == nt - 2);
            const char* a1 = cA + (size_t)(t + 1) * kstep;
            const char* a2 = last ? nA : cA + (size_t)(t + 2) * kstep; const char* b2 = last ? nB : cB + (size_t)(t + 2) * kstep;
            const char* a3 = a2 + kstep; const char* b3 = b2 + kstep;
            if (last && has_next) S.a_ready(nxt);
            if constexpr (SP2) {
            PG8_LDB(B0, 0, 0); PG8_LDB(B1, 0, 1); PG8_SCHED; PG8_LDA(At, 0, 0); PG8_STAGE(PG8_SA(1, 1), a1 + hstep, voffA);
            PG8_WAIT_V(8); PG8_WAIT_L(0); PG8_BAR; PG8_MMA(0, 0, At, B0); PG8_MMA(0, 1, At, B1); PG8_BAR; PG8_SCHED;
            PG8_LDA(At, 0, 1); PG8_STAGE(PG8_SB(0, 0), b2, voffB); PG8_STAGE(PG8_SB(0, 1), b2 + hstep, voffB); PG8_STAGE(PG8_SA(0, 0), a2, voffA);
            PG8_WAIT_V(8); PG8_WAIT_L(0); PG8_BAR; PG8_MMA(1, 0, At, B0); PG8_MMA(1, 1, At, B1); PG8_BAR; PG8_SCHED;
            PG8_LDB(B0, 1, 0); PG8_LDB(B1, 1, 1); PG8_SCHED; PG8_LDA(At, 1, 0); PG8_STAGE(PG8_SA(0, 1), a2 + hstep, voffA);
            PG8_WAIT_V(8); PG8_WAIT_L(0); PG8_BAR; PG8_MMA(0, 0, At, B0); PG8_MMA(0, 1, At, B1); PG8_BAR; PG8_SCHED;
            PG8_LDA(At, 1, 1); PG8_STAGE(PG8_SB(1, 0), b3, voffB); PG8_STAGE(PG8_SB(1, 1), b3 + hstep, voffB); PG8_STAGE(PG8_SA(1, 0), a3, voffA);
            PG8_WAIT_V(8); PG8_WAIT_L(0); PG8_BAR; PG8_MMA(1, 0, At, B0); PG8_MMA(1, 1, At, B1); PG8_BAR; PG8_SCHED;
            } else {
            PG8_LDB(B0, 0, 0); PG8_SCHED; PG8_LDA(At, 0, 0); PG8_STAGE(PG8_SA(1, 1), a1 + hstep, voffA);
            PG8_WAIT_L(8); PG8_BAR; PG8_WAIT_L(0); PG8_MMA(0, 0, At, B0); PG8_BAR; PG8_SCHED;
            PG8_LDB(B1, 0, 1); PG8_STAGE(PG8_SB(0, 0), b2, voffB);
            PG8_BAR; PG8_WAIT_L(0); PG8_MMA(0, 1, At, B1); PG8_BAR;
            PG8_LDA(At, 0, 1); PG8_STAGE(PG8_SA(0, 0), a2, voffA);
            PG8_BAR; PG8_WAIT_L(0); PG8_MMA(1, 0, At, B0); PG8_BAR; PG8_SCHED;
            PG8_STAGE(PG8_SB(0, 1), b2 + hstep, voffB);
            PG8_WAIT_V(6); PG8_BAR; PG8_MMA(1, 1, At, B1); PG8_BAR;
            PG8_LDB(B0, 1, 0); PG8_SCHED; PG8_LDA(At, 1, 0); PG8_STAGE(PG8_SA(0, 1), a2 + hstep, voffA);
            PG8_WAIT_L(8); PG8_BAR; PG8_WAIT_L(0); PG8_MMA(0, 0, At, B0); PG8_BAR; PG8_SCHED;
            PG8_LDB(B1, 1, 1); PG8_STAGE(PG8_SB(1, 0), b3, voffB);
            PG8_BAR; PG8_WAIT_L(0); PG8_MMA(0, 1, At, B1); PG8_BAR;
            PG8_LDA(At, 1, 1); PG8_STAGE(PG8_SA(1, 0), a3, voffA);
            PG8_BAR; PG8_WAIT_L(0); PG8_MMA(1, 0, At, B0); PG8_BAR; PG8_SCHED;
            PG8_STAGE(PG8_SB(1, 1), b3 + hstep, voffB);
            PG8_WAIT_V(6); PG8_BAR; PG8_MMA(1, 1, At, B1); PG8_BAR;
            }
        }
        if constexpr (ALIGN_EPI) { if (wr == 0) PG8_BAR; }
        if constexpr (!Epi::AFTER_DRAIN) { E(acc, cur, wr, wc, fr, fq); S.done(cur); }
        if (!has_next) break;
#pragma unroll
        for (int a = 0; a < 2; ++a)
#pragma unroll
            for (int b = 0; b < 2; ++b)
#pragma unroll
                for (int m = 0; m < 4; ++m)
#pragma unroll
                    for (int n = 0; n < 2; ++n) acc[a][b][m][n] = (f32x4){0.f, 0.f, 0.f, 0.f};
        cur = nxt; cA = nA; cB = nB; ++ui;
        if constexpr (ALIGN_EPI) { if (wr == 1) PG8_BAR; }
    }
    PG8_WAIT_V(0);
    if constexpr (!ALIGN_EPI) { if (wr == 0) PG8_BAR; }
    PG8_BAR;
    if constexpr (Epi::AFTER_DRAIN) { E.fused(acc, cur, wr, wc, fr, fq, lds, wid, lane); S.done(cur); }
#undef PG8_SA
#undef PG8_SB
#undef PG8_STAGE
#undef PG8_LDA
#undef PG8_LDB
#undef PG8_MMA
#undef PG8_WAIT_V
#undef PG8_WAIT_L
#undef PG8_BAR
#undef PG8_SCHED
}
}

#define LAS __attribute__((address_space(3)))
typedef unsigned short bf16_t;
typedef short bf16x8 __attribute__((ext_vector_type(8)));
typedef short s16x4 __attribute__((ext_vector_type(4)));
typedef float f32x4 __attribute__((ext_vector_type(4)));
typedef float f32x16 __attribute__((ext_vector_type(16)));
typedef unsigned u32x4 __attribute__((ext_vector_type(4)));
typedef unsigned u32x2 __attribute__((ext_vector_type(2)));
typedef float f32x2_t __attribute__((ext_vector_type(2)));
typedef __bf16 bf16x2_t __attribute__((ext_vector_type(2)));

constexpr int MTOK = 16384, DMODEL = 1024, SEQL = 4096, DFF = 2816;
constexpr float EPS = 1e-6f;
constexpr float QSCALE_D = 0.17677669529663687f * 1.4426950408889634f;
constexpr float QSCALE_M = 0.125f * 1.4426950408889634f;
constexpr int LDS_BYTES = 147456;

constexpr size_t KiB = 1024, MiB = 1u << 20;
constexpr size_t WS_SSQ = 0, WS_GVST = 256 * KiB, WS_KBAR = 384 * KiB, WS_PAR = 512 * KiB, WS_BAR = 768 * KiB;
constexpr size_t WS_COS32 = 1 * MiB, WS_SIN32 = 1 * MiB + 256 * KiB, WS_COS64 = 2 * MiB, WS_SIN64 = 2 * MiB + 512 * KiB, WS_WSB = 3 * MiB;
constexpr size_t WS_WEI = 4 * MiB, WS_WEO = 10 * MiB, WS_WFI0 = 12 * MiB, WS_WFI1 = 23 * MiB, WS_WFO0 = 34 * MiB, WS_WFO1 = 34 * MiB + 5632 * KiB;
constexpr size_t WS_WOI = 45 * MiB, WS_WOO = 49 * MiB, WS_XB = 52 * MiB, WS_MIX = 84 * MiB, WS_BIG = 116 * MiB;
constexpr size_t WS_QK = WS_BIG, WS_VT = WS_BIG + 64 * MiB, WS_ACT = WS_BIG, WS_GU = WS_BIG, WS_GV = WS_BIG + 16 * MiB, WS_CP = WS_BIG + 32 * MiB;
constexpr size_t WS_END = 212 * MiB;

struct Args { const float* in[27]; float* out; unsigned char* ws; };

__device__ __forceinline__ unsigned cvtpk(float lo, float hi) { f32x2_t v = {lo, hi}; bf16x2_t b = __builtin_convertvector(v, bf16x2_t); return __builtin_bit_cast(unsigned, b); }
__device__ __forceinline__ bf16_t f2bf(float f) { return (bf16_t)(cvtpk(f, 0.f) & 0xffffu); }
__device__ __forceinline__ float bf2f(bf16_t u) { return __uint_as_float((unsigned)u << 16); }
__device__ __forceinline__ float bflo(unsigned w) { return __uint_as_float(w << 16); }
__device__ __forceinline__ float bfhi(unsigned w) { return __uint_as_float(w & 0xffff0000u); }
__device__ __forceinline__ float dot4(f32x4 a) { return (a[0] * a[0] + a[1] * a[1]) + (a[2] * a[2] + a[3] * a[3]); }
__device__ __forceinline__ float sum4(f32x4 a) { return (a[0] + a[1]) + (a[2] + a[3]); }
__device__ __forceinline__ u32x2 pk4(f32x4 v) { u32x2 w; w.x = cvtpk(v[0], v[1]); w.y = cvtpk(v[2], v[3]); return w; }
__device__ __forceinline__ float wave_sum(float v) {
#pragma unroll
    for (int o = 1; o < 64; o <<= 1) v += __shfl_xor(v, o);
    return v;
}
__device__ __forceinline__ float hswap_max(float v) { auto rr = __builtin_amdgcn_permlane32_swap(__float_as_uint(v), __float_as_uint(v), false, false); return fmaxf(__uint_as_float(rr[0]), __uint_as_float(rr[1])); }
__device__ __forceinline__ float hswap_sum(float v) { auto rr = __builtin_amdgcn_permlane32_swap(__float_as_uint(v), __float_as_uint(v), false, false); return __uint_as_float(rr[0]) + __uint_as_float(rr[1]); }
__device__ __forceinline__ float fast_sigmoid(float x) { return __builtin_amdgcn_rcpf(1.f + __expf(-x)); }
#define MFMA32(a, b, c) __builtin_amdgcn_mfma_f32_32x32x16_bf16((a), (b), (c), 0, 0, 0)
__device__ __forceinline__ int mk_tid(int wid_s) { int lane_; asm volatile("v_mbcnt_lo_u32_b32 %0, -1, 0\n\tv_mbcnt_hi_u32_b32 %0, -1, %0" : "=v"(lane_)); return wid_s * 64 + lane_; }
__device__ __forceinline__ int crow(int reg, int h) { return (reg & 3) + 8 * (reg >> 2) + 4 * h; }


constexpr int PB_QN = 0, PB_KN = 32, PB_MQN = 64, PB_MKN = 128, PB_SUBLN = 192, PB_OBIAS = 256, PB_GLNG = 2304, PB_GLNB = 2816, PB_GBS = 3328, PB_CW = 4352, PB_CB = 20224, PB_CLNG = 20736, PB_CLNB = 21248, PB_LAM = 21760;
struct EpiDiffQK {
    static constexpr bool PERM = false, AFTER_DRAIN = false;
    unsigned char* ws;
    __device__ __forceinline__ void operator()(const f32x4 (&acc)[2][2][4][2], const pg8::Unit& u, int wr, int wc, int fr, int fq) const {
        const int type = u.pn >> 1, head = (u.pn & 1) * 4 + wc;
        const int rowb = u.pm * 256 + wr * 64 + fr;
        const float* ssq = (const float*)(ws + WS_SSQ); bf16_t* QK = (bf16_t*)(ws + WS_QK);
        const float* cos32 = (const float*)(ws + WS_COS32); const float* sin32 = (const float*)(ws + WS_SIN32);
        const float* g = (const float*)(ws + WS_PAR) + (type == 0 ? PB_QN : PB_KN); const float qs = type == 0 ? QSCALE_D : 1.f;
        const f32x4 g0 = *(const f32x4*)(g + 4 * fq), g1 = *(const f32x4*)(g + 16 + 4 * fq);
#pragma unroll
        for (int ai = 0; ai < 2; ++ai)
#pragma unroll
            for (int m = 0; m < 4; ++m) {
                const int row = rowb + ai * 128 + m * 16, t = row & (SEQL - 1);
                const float rs = rsqrtf(ssq[row] * (1.f / DMODEL) + EPS);
                const f32x4 c = *(const f32x4*)(cos32 + t * 16 + 4 * fq), s = *(const f32x4*)(sin32 + t * 16 + 4 * fq);
#pragma unroll
                for (int bj = 0; bj < 2; ++bj) {
                    const f32x4 v0 = acc[ai][bj][m][0] * rs, v1 = acc[ai][bj][m][1] * rs;
                    float ss = dot4(v0) + dot4(v1); ss += __shfl_xor(ss, 16); ss += __shfl_xor(ss, 32);
                    const float r = rsqrtf(ss * (1.f / 32.f) + EPS);
                    const f32x4 y0 = v0 * r * g0, y1 = v1 * r * g1;
                    const f32x4 o0 = (y0 * c - y1 * s) * qs, o1 = (y1 * c + y0 * s) * qs;
                    bf16_t* dst = QK + (size_t)row * 2048 + type * 512 + head * 64 + bj * 32 + 8 * fq;
                    const u32x2 p0 = pk4(o0), p1 = pk4(o1); *(u32x4*)dst = (u32x4){p0.x, p0.y, p1.x, p1.y};
                }
                asm volatile("" ::: "memory");
            }
    }
};
struct EpiMobaQK {
    static constexpr bool PERM = false, AFTER_DRAIN = false;
    unsigned char* ws;
    __device__ __forceinline__ void operator()(const f32x4 (&acc)[2][2][4][2], const pg8::Unit& u, int wr, int wc, int fr, int fq) const {
        const int type = u.pn >> 1, head = (u.pn & 1) * 4 + wc;
        const int rowb = u.pm * 256 + wr * 64 + fr;
        const float* ssq = (const float*)(ws + WS_SSQ); bf16_t* QK = (bf16_t*)(ws + WS_QK);
        const float* cos64 = (const float*)(ws + WS_COS64); const float* sin64 = (const float*)(ws + WS_SIN64);
        const float* g = (const float*)(ws + WS_PAR) + (type == 0 ? PB_MQN : PB_MKN); const float qs = type == 0 ? QSCALE_M : 1.f;
        f32x4 gg[2][2], cs[2][2];
#pragma unroll
        for (int bj = 0; bj < 2; ++bj)
#pragma unroll
            for (int n = 0; n < 2; ++n) { gg[bj][n] = *(const f32x4*)(g + 32 * bj + 16 * n + 4 * fq); cs[bj][n] = (f32x4){0.f, 0.f, 0.f, 0.f}; }
#pragma unroll
        for (int ai = 0; ai < 2; ++ai)
#pragma unroll
            for (int m = 0; m < 4; ++m) {
                const int row = rowb + ai * 128 + m * 16, t = row & (SEQL - 1);
                const float rs = rsqrtf(ssq[row] * (1.f / DMODEL) + EPS);
                f32x4 v[2][2]; float ss = 0.f;
#pragma unroll
                for (int bj = 0; bj < 2; ++bj)
#pragma unroll
                    for (int n = 0; n < 2; ++n) { v[bj][n] = acc[ai][bj][m][n] * rs; ss += dot4(v[bj][n]); }
                ss += __shfl_xor(ss, 16); ss += __shfl_xor(ss, 32);
                const float r = rsqrtf(ss * (1.f / 64.f) + EPS);
                bf16_t* dst = QK + (size_t)row * 2048 + 1024 + type * 512 + head * 64 + 16 * fq;
                u32x4 w0, w1;
#pragma unroll
                for (int n = 0; n < 2; ++n) {
                    const f32x4 c = *(const f32x4*)(cos64 + t * 32 + 16 * n + 4 * fq), s = *(const f32x4*)(sin64 + t * 32 + 16 * n + 4 * fq);
                    const f32x4 y0 = v[0][n] * r * gg[0][n], y1 = v[1][n] * r * gg[1][n];
                    const f32x4 o0 = (y0 * c - y1 * s) * qs, o1 = (y1 * c + y0 * s) * qs;
                    const u32x2 p0 = pk4(o0), p1 = pk4(o1);
                    if (n == 0) { w0.x = p0.x; w0.y = p0.y; w1.x = p1.x; w1.y = p1.y; } else { w0.z = p0.x; w0.w = p0.y; w1.z = p1.x; w1.w = p1.y; }
                    cs[0][n] += o0; cs[1][n] += o1;
                }
                *(u32x4*)dst = w0; *(u32x4*)(dst + 8) = w1;
                asm volatile("" ::: "memory");
            }
        if (type == 1) {
            float* kbar = (float*)(ws + WS_KBAR);
#pragma unroll
            for (int bj = 0; bj < 2; ++bj)
#pragma unroll
                for (int n = 0; n < 2; ++n)
#pragma unroll
                    for (int j = 0; j < 4; ++j) {
                        float x = cs[bj][n][j];
                        x += __shfl_xor(x, 1); x += __shfl_xor(x, 2); x += __shfl_xor(x, 4); x += __shfl_xor(x, 8);
                        if (fr == 0) unsafeAtomicAdd(kbar + ((size_t)u.pm * 8 + head) * 64 + 16 * fq + 8 * bj + 4 * n + j, x);
                    }
        }
    }
};
struct EpiV {
    static constexpr bool PERM = false, AFTER_DRAIN = true;
    unsigned char* ws;
    __device__ __forceinline__ void fused(f32x4 (&acc)[2][2][4][2], const pg8::Unit& u, int wr, int wc, int fr, int fq, LAS unsigned char* lds, int wid, int lane) const {
        constexpr int TP = 264;
        LAS bf16_t* T = (LAS bf16_t*)lds;
        const float* ssq = (const float*)(ws + WS_SSQ);
        const int rowb = u.pm * 256 + wr * 64 + fr;
#pragma unroll
        for (int ai = 0; ai < 2; ++ai)
#pragma unroll
            for (int m = 0; m < 4; ++m) {
                const int row = rowb + ai * 128 + m * 16, tl = ai * 128 + wr * 64 + m * 16 + fr;
                const float rs = rsqrtf(ssq[row] * (1.f / DMODEL) + EPS);
#pragma unroll
                for (int bj = 0; bj < 2; ++bj)
#pragma unroll
                    for (int n = 0; n < 2; ++n) {
                        const f32x4 v = acc[ai][bj][m][n] * rs; const int dl = 64 * wc + 32 * bj + 16 * n + 4 * fq;
                        const u32x2 w = pk4(v);
                        T[(dl + 0) * TP + tl] = (bf16_t)(w.x & 0xffffu); T[(dl + 1) * TP + tl] = (bf16_t)(w.x >> 16);
                        T[(dl + 2) * TP + tl] = (bf16_t)(w.y & 0xffffu); T[(dl + 3) * TP + tl] = (bf16_t)(w.y >> 16);
                    }
            }
        asm volatile("s_waitcnt lgkmcnt(0)" ::: "memory"); __builtin_amdgcn_s_barrier(); asm volatile("" ::: "memory");
        const int tid = wid * 64 + lane, which = u.pn >> 1, b = u.pm >> 4, t0 = (u.pm & 15) * 256;
        bf16_t* base = (bf16_t*)(ws + WS_VT) + ((size_t)((which * 4 + b) * 8 + (u.pn & 1) * 4) * 64) * SEQL + t0;
#pragma unroll 4
        for (int p = 0; p < 16; ++p) {
            const int rd = p * 16 + (tid >> 5), ch = tid & 31;
            const u32x4 w = *(LAS const u32x4*)(T + rd * TP + ch * 8);
            *(u32x4*)(base + (size_t)rd * SEQL + ch * 8) = w;
        }
    }
};

struct EpiResid {
    static constexpr bool PERM = true, AFTER_DRAIN = false;
    const bf16_t* xin; float* xout; bf16_t* xb; float* ssq;
    __device__ __forceinline__ void operator()(const f32x4 (&acc)[2][2][4][2], const pg8::Unit& u, int wr, int wc, int fr, int fq) const {
        const int rowb = u.pm * 256 + wr * 64 + fr, colb = u.pn * 256 + wc * 32 + 8 * fq;
#pragma unroll
        for (int ai = 0; ai < 2; ++ai)
#pragma unroll
            for (int m = 0; m < 4; ++m) {
                const int row = rowb + ai * 128 + m * 16; float ss = 0.f;
#pragma unroll
                for (int bj = 0; bj < 2; ++bj) {
                    const size_t off = (size_t)row * DMODEL + colb + bj * 128;
                    const u32x4 xo = *(const u32x4*)(xin + off);
                    f32x4 x0 = acc[ai][bj][m][0], x1 = acc[ai][bj][m][1];
                    x0[0] += bflo(xo.x); x0[1] += bfhi(xo.x); x0[2] += bflo(xo.y); x0[3] += bfhi(xo.y);
                    x1[0] += bflo(xo.z); x1[1] += bfhi(xo.z); x1[2] += bflo(xo.w); x1[3] += bfhi(xo.w);
                    if (xout) { *(f32x4*)(xout + off) = x0; *(f32x4*)(xout + off + 4) = x1; }
                    if (xb) { const u32x2 p0 = pk4(x0), p1 = pk4(x1); *(u32x4*)(xb + off) = (u32x4){p0.x, p0.y, p1.x, p1.y}; }
                    ss += dot4(x0) + dot4(x1);
                }
                if (ssq) { ss += __shfl_xor(ss, 16); ss += __shfl_xor(ss, 32); if (fq == 0) unsafeAtomicAdd(ssq + row, ss); }
                asm volatile("" ::: "memory");
            }
    }
};

struct EpiSwiglu {
    static constexpr bool PERM = true, AFTER_DRAIN = false;
    const float* ssq; bf16_t* act;
    __device__ __forceinline__ void operator()(const f32x4 (&acc)[2][2][4][2], const pg8::Unit& u, int wr, int wc, int fr, int fq) const {
        const int rowb = u.pm * 256 + wr * 64 + fr, colb = u.pn * 128 + wc * 32 + 8 * fq;
#pragma unroll
        for (int ai = 0; ai < 2; ++ai)
#pragma unroll
            for (int m = 0; m < 4; ++m) {
                const int row = rowb + ai * 128 + m * 16;
                const float rs = rsqrtf(ssq[row] * (1.f / DMODEL) + EPS);
                u32x4 w;
#pragma unroll
                for (int n = 0; n < 2; ++n) {
                    const f32x4 g = acc[ai][0][m][n] * rs, uu = acc[ai][1][m][n] * rs; f32x4 a;
#pragma unroll
                    for (int j = 0; j < 4; ++j) a[j] = g[j] * fast_sigmoid(g[j]) * uu[j];
                    const u32x2 p = pk4(a); if (n == 0) { w.x = p.x; w.y = p.y; } else { w.z = p.x; w.w = p.y; }
                }
                *(u32x4*)(act + (size_t)row * DFF + colb) = w;
                asm volatile("" ::: "memory");
            }
    }
};

struct EpiOddIn {
    static constexpr bool PERM = true, AFTER_DRAIN = false;
    unsigned char* ws;
    __device__ __forceinline__ void operator()(const f32x4 (&acc)[2][2][4][2], const pg8::Unit& u, int wr, int wc, int fr, int fq) const {
        const int rowb = u.pm * 256 + wr * 64 + fr;
        const float* ssq = (const float*)(ws + WS_SSQ) + 2 * MTOK; const float* bias = (const float*)(ws + WS_PAR) + PB_OBIAS;
        bf16_t* GU = (bf16_t*)(ws + WS_GU); bf16_t* GV = (bf16_t*)(ws + WS_GV); bf16_t* CP = (bf16_t*)(ws + WS_CP); float* gvst = (float*)(ws + WS_GVST);
        if (u.pn < 4) {
            const int colb = u.pn * 256 + wc * 32 + 8 * fq;
            bf16_t* dstb = u.pn < 2 ? GU : GV; const int cadj = u.pn < 2 ? 0 : 512;
#pragma unroll
            for (int ai = 0; ai < 2; ++ai)
#pragma unroll
                for (int m = 0; m < 4; ++m) {
                    const int row = rowb + ai * 128 + m * 16;
                    const float rs = rsqrtf(ssq[row] * (1.f / DMODEL) + EPS); float s1 = 0.f, s2 = 0.f;
#pragma unroll
                    for (int bj = 0; bj < 2; ++bj) {
                        u32x4 w;
#pragma unroll
                        for (int n = 0; n < 2; ++n) {
                            const int col = colb + bj * 128 + n * 4;
                            const f32x4 x = acc[ai][bj][m][n] * rs + *(const f32x4*)(bias + col); f32x4 y;
#pragma unroll
                            for (int j = 0; j < 4; ++j) { const float z = 1.5957691216057308f * (x[j] + 0.044715f * x[j] * x[j] * x[j]); y[j] = x[j] * fast_sigmoid(z); }
                            const u32x2 p = pk4(y); if (n == 0) { w.x = p.x; w.y = p.y; } else { w.z = p.x; w.w = p.y; }
                            s1 += sum4(y); s2 += dot4(y);
                        }
                        *(u32x4*)(dstb + (size_t)row * 512 + colb + bj * 128 - cadj) = w;
                    }
                    if (u.pn >= 2) {
                        s1 += __shfl_xor(s1, 16); s1 += __shfl_xor(s1, 32); s2 += __shfl_xor(s2, 16); s2 += __shfl_xor(s2, 32);
                        if (fq == 0) { unsafeAtomicAdd(gvst + 2 * row, s1); unsafeAtomicAdd(gvst + 2 * row + 1, s2); }
                    }
                    asm volatile("" ::: "memory");
                }
        } else {
            const int offb = (u.pn - 4) * 128 + wc * 32 + 8 * fq;
#pragma unroll
            for (int ai = 0; ai < 2; ++ai)
#pragma unroll
                for (int m = 0; m < 4; ++m) {
                    const int row = rowb + ai * 128 + m * 16;
                    const float rs = rsqrtf(ssq[row] * (1.f / DMODEL) + EPS);
                    u32x4 w;
#pragma unroll
                    for (int n = 0; n < 2; ++n) {
                        const int off = offb + n * 4;
                        const f32x4 a = acc[ai][0][m][n] * rs + *(const f32x4*)(bias + 1024 + off), gt = acc[ai][1][m][n] * rs + *(const f32x4*)(bias + 1536 + off); f32x4 y;
#pragma unroll
                        for (int j = 0; j < 4; ++j) y[j] = a[j] * fast_sigmoid(gt[j]);
                        const u32x2 p = pk4(y); if (n == 0) { w.x = p.x; w.y = p.y; } else { w.z = p.x; w.w = p.y; }
                    }
                    *(u32x4*)(CP + (size_t)row * 512 + offb) = w;
                    asm volatile("" ::: "memory");
                }
        }
    }
};

__device__ __forceinline__ int map_row(int mode, int n0) {
    if (mode == 1) { const int seg = n0 >> 9, nseg = seg == 2 ? 4 : (seg == 3 ? 2 : (seg == 4 ? 3 : seg)), l = n0 & 511, pl = l >> 8, l2 = l & 255, wc = l2 >> 6, bj = (l2 >> 5) & 1;
                     return nseg * 512 + pl * 256 + bj * 128 + wc * 32; }
    if (mode == 2) { if (n0 < DFF) return (n0 >> 7) * 256 + (n0 & 127); const int n1 = n0 - DFF; return (n1 >> 7) * 256 + 128 + (n1 & 127); }
    if (mode == 3) { if (n0 < 1024) return n0; if (n0 < 1536) { const int n1 = n0 - 1024; return (4 + (n1 >> 7)) * 256 + (n1 & 127); }
                     const int n1 = n0 - 1536; return (4 + (n1 >> 7)) * 256 + 128 + (n1 & 127); }
    return n0;
}
constexpr int TRP = 65;
__device__ __forceinline__ void tr_item(const float* W, int K, int N, bf16_t* WT, int mode, const float* gk, LAS float* scr, int item, int lane) {
    const int nblk = N / 64, kb = item / nblk, nb = item % nblk, k0 = 64 * kb, n0 = 64 * nb;
    f32x4 v[16];
#pragma unroll
    for (int i = 0; i < 16; ++i) { const int kk = 4 * i + (lane >> 4); v[i] = *(const f32x4*)(W + (size_t)(k0 + kk) * N + n0 + (lane & 15) * 4); }
#pragma unroll
    for (int i = 0; i < 16; ++i) { const int kk = 4 * i + (lane >> 4); f32x4 w = v[i]; if (gk) w = w * gk[k0 + kk]; LAS float* d = scr + kk * TRP + (lane & 15) * 4;
        d[0] = w[0]; d[1] = w[1]; d[2] = w[2]; d[3] = w[3]; }
    asm volatile("s_waitcnt lgkmcnt(0)" ::: "memory");
    const int c = lane & 7, nn = lane >> 3;
#pragma unroll
    for (int j = 0; j < 8; ++j) {
        const int n = nn + 8 * j;
        const LAS float* s = scr + (8 * c) * TRP + n;
        u32x4 o; o.x = cvtpk(s[0 * TRP], s[1 * TRP]); o.y = cvtpk(s[2 * TRP], s[3 * TRP]); o.z = cvtpk(s[4 * TRP], s[5 * TRP]); o.w = cvtpk(s[6 * TRP], s[7 * TRP]);
        *(u32x4*)(WT + (size_t)(map_row(mode, n0 + (n & 32)) + (n & 31)) * K + k0 + 8 * c) = o;
    }
    asm volatile("s_waitcnt lgkmcnt(0)" ::: "memory");
}

constexpr int I_EI = 16 * 48, I_EO = 16 * 16, I_FI = 16 * 88, I_FO = 44 * 16, I_OI = 16 * 32, I_OO = 16 * 16;
__device__ __forceinline__ void convert_late(const Args& a, unsigned char* ws, LAS unsigned char* lds, int gw, int nw, int wid) {
    const int lane = mk_tid(wid) & 63;
    LAS float* scr = (LAS float*)(lds + wid * (64 * TRP * 4));
    constexpr int NITEMS = I_FI + I_FO + I_OI + I_OO;
    for (int it = gw; it < NITEMS; it += nw) {
        int r = it;
        if (r < I_FI) { tr_item(a.in[3] + (size_t)1024 * 5632, 1024, 5632, (bf16_t*)(ws + WS_WFI1), 2, a.in[2] + 1024, scr, r, lane); continue; } r -= I_FI;
        if (r < I_FO) { tr_item(a.in[4] + (size_t)2816 * 1024, 2816, 1024, (bf16_t*)(ws + WS_WFO1), 0, nullptr, scr, r, lane); continue; } r -= I_FO;
        if (r < I_OI) { tr_item(a.in[16], 1024, 2048, (bf16_t*)(ws + WS_WOI), 3, a.in[1] + 1024, scr, r, lane); continue; } r -= I_OI;
        tr_item(a.in[18], 1024, 1024, (bf16_t*)(ws + WS_WOO), 0, nullptr, scr, r, lane);
    }
}
__device__ __forceinline__ void prologue(const Args& a, LAS unsigned char* lds, int vcu, int G, int wid) {
    const int tid = mk_tid(wid), lane = tid & 63;
    unsigned char* ws = a.ws;
    LAS float* scr = (LAS float*)(lds + wid * (64 * TRP * 4));
    const int gw = vcu * 8 + wid, NGW = G * 8;
    constexpr int NITEMS = I_EI + I_EO + I_FI + I_FO;
    for (int it = gw; it < NITEMS; it += NGW) {
        int r = it;
        if (r < I_EI) { tr_item(a.in[5], 1024, 3072, (bf16_t*)(ws + WS_WEI), 1, a.in[1], scr, r, lane); continue; } r -= I_EI;
        if (r < I_EO) { tr_item(a.in[6], 1024, 1024, (bf16_t*)(ws + WS_WEO), 0, nullptr, scr, r, lane); continue; } r -= I_EO;
        if (r < I_FI) { tr_item(a.in[3], 1024, 5632, (bf16_t*)(ws + WS_WFI0), 2, a.in[2], scr, r, lane); continue; } r -= I_FI;
        tr_item(a.in[4], 2816, 1024, (bf16_t*)(ws + WS_WFO0), 0, nullptr, scr, r, lane);
    }
    float* ssq = (float*)(ws + WS_SSQ); bf16_t* XB = (bf16_t*)(ws + WS_XB);
    for (int m = gw; m < MTOK; m += NGW) {
        const f32x4* xr = (const f32x4*)(a.in[0] + (size_t)m * DMODEL) + lane; u32x2* o8 = (u32x2*)(XB + (size_t)m * DMODEL) + lane; float s = 0.f;
#pragma unroll
        for (int j = 0; j < 4; ++j) { const f32x4 v = xr[64 * j]; s += dot4(v); o8[64 * j] = pk4(v); }
        s = wave_sum(s); if (lane == 0) ssq[m] = s;
    }
    const int gt = vcu * 512 + tid, NGT = G * 512;
    for (int i = 16384 + gt; i < 131072; i += NGT) ssq[i] = 0.f;
    for (int i = gt; i < SEQL * 48; i += NGT) {
        const int t = i / 48, e = i % 48; const bool small = e < 16; const int fi = small ? e : e - 16;
        const float inv = 1.0f / powf(10000.0f, small ? (float)fi * (1.f / 16.f) : (float)fi * (1.f / 32.f));
        const float ang = (float)t * inv;
        const double ad = (double)ang, n = rint(ad * 0.15915494309189535), rr = ad - n * 6.283185307179586;
        const float rf = (float)rr, cv = __cosf(rf), sv = __sinf(rf);
        if (small) { ((float*)(ws + WS_COS32))[t * 16 + fi] = cv; ((float*)(ws + WS_SIN32))[t * 16 + fi] = sv; }
        else { ((float*)(ws + WS_COS64))[t * 32 + fi] = cv; ((float*)(ws + WS_SIN64))[t * 32 + fi] = sv; }
    }
    for (int i = gt; i < 8 * 128 * 128; i += NGT) { const int t = (i >> 7) & 127, s = i & 127; ((bf16_t*)(ws + WS_WSB))[i] = s <= t ? f2bf(a.in[21][i]) : (bf16_t)0; }
    if (vcu == 0 && wid == 0) {
        float p1 = 0.f, p2 = 0.f;
        if (lane < 32) { p1 = a.in[9][lane] * a.in[10][lane]; p2 = a.in[11][lane] * a.in[12][lane]; }
        p1 = wave_sum(p1); p2 = wave_sum(p2);
        if (lane == 0) ((float*)(ws + WS_PAR))[PB_LAM] = expf(p1) - expf(p2) + 0.2f;
    }
    {
        float* pb = (float*)(ws + WS_PAR);
        for (int i = gt; i < PB_LAM; i += NGT) {
            float v;
            if (i < PB_KN) v = a.in[7][i - PB_QN]; else if (i < PB_MQN) v = a.in[8][i - PB_KN]; else if (i < PB_MKN) v = a.in[14][i - PB_MQN]; else if (i < PB_SUBLN) v = a.in[15][i - PB_MKN];
            else if (i < PB_OBIAS) v = a.in[13][i - PB_SUBLN]; else if (i < PB_GLNG) v = a.in[17][i - PB_OBIAS]; else if (i < PB_GLNB) v = a.in[19][i - PB_GLNG]; else if (i < PB_GBS) v = a.in[20][i - PB_GLNB];
            else if (i < PB_CW) v = a.in[22][i - PB_GBS]; else if (i < PB_CB) v = a.in[23][i - PB_CW]; else if (i < PB_CLNG) v = a.in[24][i - PB_CB]; else if (i < PB_CLNB) v = a.in[25][i - PB_CLNG]; else v = a.in[26][i - PB_CLNB];
            pb[i] = v;
        }
    }
}

constexpr int KPITCH = 144, VPITCH = 272, KBUF = 128 * KPITCH, VBUF = 64 * VPITCH;
template <bool DIFF>
__device__ __forceinline__ void attn_unit(LAS unsigned char* lds, unsigned char* ws, int b, int hd, int qb, int wid) {
    const float* subln_g = (const float*)(ws + WS_PAR) + PB_SUBLN; bf16_t* MIX = (bf16_t*)(ws + WS_MIX);
    constexpr int NM = DIFF ? 2 : 1;
    const int tid = mk_tid(wid), lane = tid & 63, r = lane & 31, h = lane >> 5;
    const bf16_t* QK = (const bf16_t*)(ws + WS_QK); const bf16_t* VT = (const bf16_t*)(ws + WS_VT);
    const int q0 = qb * 256, qw = q0 + 32 * wid, qrow = qw + r;
    const size_t grow = (size_t)b * SEQL + qrow;
    const bf16_t* Qp = QK + grow * 2048 + (DIFF ? 0 : 1024) + hd * 64;
    const bf16_t* Kg = QK + (size_t)b * SEQL * 2048 + (DIFF ? 512 : 1536) + hd * 64;
    const bf16_t* Vg = VT + ((size_t)(((DIFF ? 0 : 1) * 4 + b) * 8 + hd) * 64) * SEQL;
    bf16x8 qf[4];
#pragma unroll
    for (int i = 0; i < 4; ++i) qf[i] = *(const bf16x8*)(Qp + 16 * i + 8 * h);
    unsigned sel = 0u;
    if (!DIFF) {
        float qv[32];
#pragma unroll
        for (int i = 0; i < 4; ++i) { const u32x4 w = *(const u32x4*)(Qp + 32 * h + 8 * i);
            qv[8 * i + 0] = bflo(w.x); qv[8 * i + 1] = bfhi(w.x); qv[8 * i + 2] = bflo(w.y); qv[8 * i + 3] = bfhi(w.y);
            qv[8 * i + 4] = bflo(w.z); qv[8 * i + 5] = bfhi(w.z); qv[8 * i + 6] = bflo(w.w); qv[8 * i + 7] = bfhi(w.w); }
        float g[15];
        const float* kb0 = (const float*)(ws + WS_KBAR) + ((size_t)(b * 16) * 8 + hd) * 64 + 32 * h;
#pragma unroll
        for (int n = 0; n < 15; ++n) {
            float acc = 0.f;
            if (n < qb) {
                const float* kb = kb0 + (size_t)n * 512;
#pragma unroll
                for (int i = 0; i < 8; ++i) { const f32x4 kv = *(const f32x4*)(kb + 4 * i); acc += qv[4 * i] * kv[0] + qv[4 * i + 1] * kv[1] + qv[4 * i + 2] * kv[2] + qv[4 * i + 3] * kv[3]; }
                acc = hswap_sum(acc);
            }
            g[n] = acc;
        }
#pragma unroll
        for (int pass = 0; pass < 3; ++pass) {
            float best = -INFINITY; int bi = -1;
#pragma unroll
            for (int n = 0; n < 15; ++n) { const bool ok = (n < qb) && !((sel >> n) & 1u) && (g[n] > best); best = ok ? g[n] : best; bi = ok ? n : bi; }
            if (bi >= 0) sel |= 1u << bi;
        }
    }
    f32x16 o[NM][2]; float lrun[NM];
#pragma unroll
    for (int mp = 0; mp < NM; ++mp) { lrun[mp] = 0.f;
#pragma unroll
        for (int d = 0; d < 2; ++d)
#pragma unroll
            for (int i = 0; i < 16; ++i) o[mp][d][i] = 0.f; }
    const int nT = (q0 + 256) / 128;
    const int krow = tid >> 2, kch = tid & 3, vrow = tid >> 3, vch = tid & 7;
    const bf16_t* ksrc = Kg + (size_t)krow * 2048 + kch * 16;
    const bf16_t* vsrc = Vg + (size_t)vrow * SEQL + vch * 16;
    LAS unsigned char* kdst = lds + krow * KPITCH + kch * 32;
    LAS unsigned char* vdst = lds + 2 * KBUF + vrow * VPITCH + vch * 32;
    u32x4 kreg0 = *(const u32x4*)ksrc, kreg1 = *(const u32x4*)(ksrc + 8), vreg0 = *(const u32x4*)vsrc, vreg1 = *(const u32x4*)(vsrc + 8);
#define ATT_STAGE(bo) do { LAS unsigned char* kd_ = kdst + (bo) * KBUF; LAS unsigned char* vd_ = vdst + (bo) * VBUF; \
        *(LAS u32x4*)kd_ = kreg0; *(LAS u32x4*)(kd_ + 16) = kreg1; \
        *(LAS u32x4*)vd_ = (u32x4){vreg0.x, vreg0.y, vreg1.x, vreg1.y}; *(LAS u32x4*)(vd_ + 16) = (u32x4){vreg0.z, vreg0.w, vreg1.z, vreg1.w}; } while (0)
    ATT_STAGE(0);
    __syncthreads();
    for (int t = 0; t < nT; ++t) {
        const int buf = t & 1;
        if (t + 1 < nT) { const bf16_t* kp_ = ksrc + (size_t)(t + 1) * 128 * 2048; const bf16_t* vp_ = vsrc + (t + 1) * 128;
            kreg0 = *(const u32x4*)kp_; kreg1 = *(const u32x4*)(kp_ + 8); vreg0 = *(const u32x4*)vp_; vreg1 = *(const u32x4*)(vp_ + 8); }
#pragma nounroll
        for (int sb = 0; sb < 2; ++sb) {
        const int kv0 = t * 128 + sb * 64, tt = 2 * t + sb;
        bool active = kv0 <= qw + 31;
        const bool past = !DIFF && (tt >> 2) < qb;
        const bool use = past ? ((sel >> (tt >> 2)) & 1u) != 0u : true;
        if (past) active = active && (__ballot(use) != 0ull);
        if (active) {
            LAS const unsigned char* Kt = lds + buf * KBUF + sb * (64 * KPITCH); LAS const unsigned char* Vt = lds + 2 * KBUF + buf * VBUF + sb * 128;
            f32x16 s[NM][2];
#pragma unroll
            for (int kvb = 0; kvb < 2; ++kvb) {
                LAS const unsigned char* kp = Kt + (kvb * 32 + r) * KPITCH + h * 16;
                bf16x8 kf[4];
#pragma unroll
                for (int i = 0; i < 4; ++i) kf[i] = *(LAS const bf16x8*)(kp + 32 * i);
                f32x16 z;
#pragma unroll
                for (int i = 0; i < 16; ++i) z[i] = 0.f;
                if (DIFF) { s[0][kvb] = MFMA32(kf[0], qf[0], z); s[0][kvb] = MFMA32(kf[1], qf[1], s[0][kvb]);
                            s[NM - 1][kvb] = MFMA32(kf[2], qf[2], z); s[NM - 1][kvb] = MFMA32(kf[3], qf[3], s[NM - 1][kvb]); }
                else { s[0][kvb] = MFMA32(kf[0], qf[0], z); s[0][kvb] = MFMA32(kf[1], qf[1], s[0][kvb]); s[0][kvb] = MFMA32(kf[2], qf[2], s[0][kvb]); s[0][kvb] = MFMA32(kf[3], qf[3], s[0][kvb]); }
            }
            if (kv0 + 63 > qw) {
#pragma unroll
                for (int kvb = 0; kvb < 2; ++kvb)
#pragma unroll
                    for (int i = 0; i < 16; ++i) { const bool dead = kv0 + 32 * kvb + crow(i, h) > qrow;
#pragma unroll
                        for (int mp = 0; mp < NM; ++mp) s[mp][kvb][i] = dead ? -INFINITY : s[mp][kvb][i]; }
            }
#pragma unroll
            for (int mp = 0; mp < NM; ++mp) {
                float rsum = 0.f;
#pragma unroll
                for (int kvb = 0; kvb < 2; ++kvb)
#pragma unroll
                    for (int i = 0; i < 16; ++i) { const float p = __builtin_amdgcn_exp2f(s[mp][kvb][i]); s[mp][kvb][i] = p; rsum += p; }
                lrun[mp] += use ? rsum : 0.f;
            }
#pragma unroll
            for (int kvb = 0; kvb < 2; ++kvb)
#pragma unroll
                for (int ss = 0; ss < 2; ++ss) {
                    bf16x8 pb[NM];
#pragma unroll
                    for (int mp = 0; mp < NM; ++mp) { u32x4 w; w.x = cvtpk(s[mp][kvb][8 * ss + 0], s[mp][kvb][8 * ss + 1]); w.y = cvtpk(s[mp][kvb][8 * ss + 2], s[mp][kvb][8 * ss + 3]);
                        w.z = cvtpk(s[mp][kvb][8 * ss + 4], s[mp][kvb][8 * ss + 5]); w.w = cvtpk(s[mp][kvb][8 * ss + 6], s[mp][kvb][8 * ss + 7]);
                        if (past) { w.x = use ? w.x : 0u; w.y = use ? w.y : 0u; w.z = use ? w.z : 0u; w.w = use ? w.w : 0u; }
                        pb[mp] = __builtin_bit_cast(bf16x8, w); }
#pragma unroll
                    for (int d = 0; d < 2; ++d) {
                        const bf16x8 va = *(LAS const bf16x8*)(Vt + (32 * d + r) * VPITCH + (kvb * 32 + 16 * ss + 8 * h) * 2);
#pragma unroll
                        for (int mp = 0; mp < NM; ++mp) o[mp][d] = MFMA32(va, pb[mp], o[mp][d]);
                    }
                }
        }
        }
        if (t + 1 < nT) ATT_STAGE(buf ^ 1);
        __syncthreads();
    }
#undef ATT_STAGE
    float inv[NM];
#pragma unroll
    for (int mp = 0; mp < NM; ++mp) inv[mp] = 1.f / hswap_sum(lrun[mp]);
    float rn = 1.f;
    if (DIFF) {
        const float lam = ((const float*)(ws + WS_PAR))[PB_LAM]; float ss = 0.f;
#pragma unroll
        for (int d = 0; d < 2; ++d)
#pragma unroll
            for (int i = 0; i < 16; ++i) { const float v = o[0][d][i] * inv[0] - lam * (o[NM - 1][d][i] * inv[NM - 1]); o[0][d][i] = v; ss += v * v; }
        ss = hswap_sum(ss);
        rn = rsqrtf(ss * (1.f / 64.f) + EPS) * 0.8f;
    }
    bf16_t* orow = MIX + grow * DMODEL + (DIFF ? 0 : 512) + hd * 64;
#pragma unroll
    for (int d = 0; d < 2; ++d) {
        u32x2 pk[4];
#pragma unroll
        for (int g4 = 0; g4 < 4; ++g4) { const int d0 = 32 * d + 8 * g4 + 4 * h; f32x4 v;
            if (DIFF) { const f32x4 gw = *(const f32x4*)(subln_g + d0); v[0] = o[0][d][4 * g4] * rn * gw[0]; v[1] = o[0][d][4 * g4 + 1] * rn * gw[1]; v[2] = o[0][d][4 * g4 + 2] * rn * gw[2]; v[3] = o[0][d][4 * g4 + 3] * rn * gw[3]; }
            else { v[0] = o[0][d][4 * g4] * inv[0]; v[1] = o[0][d][4 * g4 + 1] * inv[0]; v[2] = o[0][d][4 * g4 + 2] * inv[0]; v[3] = o[0][d][4 * g4 + 3] * inv[0]; }
            pk[g4] = pk4(v); }
#pragma unroll
        for (int gp = 0; gp < 2; ++gp) {
            const auto r0 = __builtin_amdgcn_permlane32_swap(pk[2 * gp].x, pk[2 * gp + 1].x, false, false);
            const auto r1 = __builtin_amdgcn_permlane32_swap(pk[2 * gp].y, pk[2 * gp + 1].y, false, false);
            const u32x4 w = {r0[0], r1[0], r0[1], r1[1]};
            *(u32x4*)(orow + 32 * d + 8 * (2 * gp + h)) = w;
        }
    }
}

__device__ __forceinline__ void gmlp_item(LAS unsigned char* lds, unsigned char* ws, int item, int wid) {
    const int tid = mk_tid(wid), lane = tid & 63, r = lane & 31, h = lane >> 5;
    const float* pb = (const float*)(ws + WS_PAR);
    const bf16_t* GU = (const bf16_t*)(ws + WS_GU); const bf16_t* GV = (const bf16_t*)(ws + WS_GV); const float* gvst = (const float*)(ws + WS_GVST);
    const bf16_t* WSB = (const bf16_t*)(ws + WS_WSB); bf16_t* MIX = (bf16_t*)(ws + WS_MIX);
    const int ch = item >> 2, g0 = (item & 3) * 2; const size_t row0 = (size_t)ch * 128;
    constexpr int GP = 136;
    const int mb = wid & 3, grp = wid >> 2, g = g0 + grp;
    const int s = tid >> 2, dc = (tid & 3) * 32; const size_t frow = row0 + s;
    const bf16_t* src = GV + frow * 512 + g0 * 64 + dc;
    const u32x4 w0 = *(const u32x4*)src, w1 = *(const u32x4*)(src + 8), w2 = *(const u32x4*)(src + 16), w3 = *(const u32x4*)(src + 24);
    const float s1 = gvst[2 * frow], s2 = gvst[2 * frow + 1];
    const bf16_t* Wp = WSB + ((size_t)g * 128 + 32 * mb + r) * 128 + 8 * h;
    bf16x8 wv[8];
#pragma unroll
    for (int kk = 0; kk < 8; ++kk) wv[kk] = *(const bf16x8*)(Wp + 16 * kk);
    const int t = 32 * mb + r; const size_t orow = row0 + t;
    const float bs = pb[PB_GBS + g * 128 + t];
    u32x2 guv[2][4];
#pragma unroll
    for (int nb = 0; nb < 2; ++nb)
#pragma unroll
        for (int gp = 0; gp < 2; ++gp) {
            const u32x4 w = *(const u32x4*)(GU + orow * 512 + g * 64 + 32 * nb + 8 * (2 * gp + h));
            const auto rx = __builtin_amdgcn_permlane32_swap(w.x, w.z, false, false); const auto ry = __builtin_amdgcn_permlane32_swap(w.y, w.w, false, false);
            guv[nb][2 * gp] = (u32x2){rx[0], ry[0]}; guv[nb][2 * gp + 1] = (u32x2){rx[1], ry[1]};
        }
    {
        const float mean = s1 * (1.f / 512.f), var = fmaxf(s2 * (1.f / 512.f) - mean * mean, 0.f), rstd = rsqrtf(var + EPS);
        const float* lg = pb + PB_GLNG + g0 * 64 + dc; const float* lb = pb + PB_GLNB + g0 * 64 + dc;
        LAS bf16_t* dst = (LAS bf16_t*)lds + dc * GP + s;
        const unsigned ww[16] = {w0.x, w0.y, w0.z, w0.w, w1.x, w1.y, w1.z, w1.w, w2.x, w2.y, w2.z, w2.w, w3.x, w3.y, w3.z, w3.w};
#pragma unroll
        for (int i = 0; i < 16; ++i) {
            const float y0 = (bflo(ww[i]) - mean) * rstd * lg[2 * i] + lb[2 * i], y1 = (bfhi(ww[i]) - mean) * rstd * lg[2 * i + 1] + lb[2 * i + 1];
            dst[(2 * i) * GP] = f2bf(y0); dst[(2 * i + 1) * GP] = f2bf(y1);
        }
    }
    __syncthreads();
    f32x16 acc[2];
#pragma unroll
    for (int i = 0; i < 16; ++i) { acc[0][i] = 0.f; acc[1][i] = 0.f; }
    LAS const unsigned char* Ap = lds + ((grp * 64 + r) * GP + 8 * h) * 2;
#pragma unroll
    for (int kk = 0; kk < 8; ++kk)
        if (kk < 2 * (mb + 1)) { const bf16x8 a0 = *(LAS const bf16x8*)(Ap + 32 * kk), a1 = *(LAS const bf16x8*)(Ap + 32 * GP * 2 + 32 * kk);
            acc[0] = MFMA32(a0, wv[kk], acc[0]); acc[1] = MFMA32(a1, wv[kk], acc[1]); }
#pragma unroll
    for (int nb = 0; nb < 2; ++nb) {
        u32x2 pk[4];
#pragma unroll
        for (int g4 = 0; g4 < 4; ++g4) { const u32x2 u = guv[nb][g4]; f32x4 v;
            v[0] = bflo(u.x) * (acc[nb][4 * g4] + bs); v[1] = bfhi(u.x) * (acc[nb][4 * g4 + 1] + bs); v[2] = bflo(u.y) * (acc[nb][4 * g4 + 2] + bs); v[3] = bfhi(u.y) * (acc[nb][4 * g4 + 3] + bs);
            pk[g4] = pk4(v); }
#pragma unroll
        for (int gp = 0; gp < 2; ++gp) {
            const auto r0 = __builtin_amdgcn_permlane32_swap(pk[2 * gp].x, pk[2 * gp + 1].x, false, false);
            const auto r1 = __builtin_amdgcn_permlane32_swap(pk[2 * gp].y, pk[2 * gp + 1].y, false, false);
            *(u32x4*)(MIX + orow * DMODEL + g * 64 + 32 * nb + 8 * (2 * gp + h)) = (u32x4){r0[0], r1[0], r0[1], r1[1]};
        }
    }
    __syncthreads();
}
__device__ __forceinline__ void conv_item(LAS unsigned char* lds, unsigned char* ws, int item, int wid) {
    const float* pb = (const float*)(ws + WS_PAR);
    const int tid = mk_tid(wid), lane = tid & 63;
    const bf16_t* CP = (const bf16_t*)(ws + WS_CP); bf16_t* MIX = (bf16_t*)(ws + WS_MIX);
    constexpr int CT = 64, HT = 32;
    const size_t row0 = (size_t)item * CT; const int half = tid >> 8, c2 = (tid & 255) * 2;
    const size_t hrow0 = row0 + half * HT; const int pos0 = (int)(hrow0 & (SEQL - 1));
    f32x2_t in[HT + 30];
#pragma unroll
    for (int i = 0; i < HT + 30; ++i) { const int p = pos0 + i - 30; unsigned w = 0u; if (p >= 0) w = *(const unsigned*)(CP + (hrow0 + i - 30) * 512 + c2); in[i] = (f32x2_t){bflo(w), bfhi(w)}; }
    f32x2_t w[31];
#pragma unroll
    for (int k = 0; k < 31; ++k) w[k] = *(const f32x2_t*)(pb + PB_CW + k * 512 + c2);
    const f32x2_t bb = *(const f32x2_t*)(pb + PB_CB + c2);
    LAS float* outl = (LAS float*)lds;
#pragma unroll
    for (int t = 0; t < HT; ++t) { f32x2_t acc = bb;
#pragma unroll
        for (int k = 0; k < 31; ++k) acc = __builtin_elementwise_fma(w[k], in[t + k], acc);
        *(LAS f32x2_t*)(outl + (half * HT + t) * 512 + c2) = acc; }
    __syncthreads();
    const f32x4 g0 = *(const f32x4*)(pb + PB_CLNG + lane * 8), g1 = *(const f32x4*)(pb + PB_CLNG + lane * 8 + 4), b0 = *(const f32x4*)(pb + PB_CLNB + lane * 8), b1 = *(const f32x4*)(pb + PB_CLNB + lane * 8 + 4);
#pragma unroll
    for (int tt = 0; tt < CT / 8; ++tt) {
        const int t = (CT / 8) * wid + tt;
        const f32x4 v0 = *(LAS const f32x4*)(outl + t * 512 + lane * 8), v1 = *(LAS const f32x4*)(outl + t * 512 + lane * 8 + 4);
        const float s1 = wave_sum(sum4(v0) + sum4(v1)), mean = s1 * (1.f / 512.f);
        const f32x4 d0 = v0 - mean, d1 = v1 - mean;
        const float s2 = wave_sum(dot4(d0) + dot4(d1)), rstd = rsqrtf(s2 * (1.f / 512.f) + EPS);
        f32x4 y0 = d0 * rstd * g0 + b0, y1 = d1 * rstd * g1 + b1;
#pragma unroll
        for (int j = 0; j < 4; ++j) { y0[j] = y0[j] * fast_sigmoid(y0[j]); y1[j] = y1[j] * fast_sigmoid(y1[j]); }
        u32x4 o; o.x = cvtpk(y0[0], y0[1]); o.y = cvtpk(y0[2], y0[3]); o.z = cvtpk(y1[0], y1[1]); o.w = cvtpk(y1[2], y1[3]);
        *(u32x4*)(MIX + (row0 + t) * DMODEL + 512 + lane * 8) = o;
    }
    __syncthreads();
}

#define XB_TMO      128
#define XB_XCNT(j)  (256  + 64 * (j))
#define XB_XSUB(j)  (1280 + 64 * (j))
#define XB_XGEN(j)  (2304 + 64 * (j))
#define XB_TOP      3328
#define XB_TOPGEN   3392
#define XCD_BAR_WORDS 3456
#define XB_SPIN_CAP (1u << 18)

__device__ __forceinline__ unsigned xb_ld(unsigned* p)              { return __hip_atomic_load(p, __ATOMIC_RELAXED, __HIP_MEMORY_SCOPE_AGENT); }
__device__ __forceinline__ unsigned xb_add(unsigned* p, unsigned v) { return __hip_atomic_fetch_add(p, v, __ATOMIC_RELAXED, __HIP_MEMORY_SCOPE_AGENT); }
__device__ __forceinline__ unsigned xb_xcc_id() { return (unsigned)__builtin_amdgcn_s_getreg((3 << 11) | 20) & 0xFu; }
#define XB_SPIN(cond, bar) do { unsigned _sp = 0; while (cond) { __builtin_amdgcn_s_sleep(1); \
    if ((++_sp & 255u) == 0u) { if (xb_ld(&(bar)[XB_TMO])) break; if (_sp > XB_SPIN_CAP) { atomicAdd(&(bar)[XB_TMO], 1u); break; } } } } while (0)

struct XcdBarrier {
    unsigned* bar; unsigned x;
    volatile LAS unsigned* st;
};

__device__ __forceinline__ XcdBarrier xcd_barrier_post(unsigned* bar, volatile LAS unsigned* st) {
    XcdBarrier b; b.bar = bar; b.x = xb_xcc_id(); b.st = st;
    if (threadIdx.x == 0) (void)xb_add(&bar[XB_XCNT(b.x)], 1u);
    return b;
}
__device__ __forceinline__ void xcd_barrier_complete(unsigned* bar, unsigned x, unsigned& nloc, unsigned& nx) {
    const unsigned G = gridDim.x * gridDim.y * gridDim.z;
    unsigned sum, cnt, mine, sp = 0u;
    for (;;) {
        sum = 0u; cnt = 0u; mine = 0u;
#pragma unroll
        for (unsigned j = 0; j < 16; ++j) { const unsigned c = xb_ld(&bar[XB_XCNT(j)]); sum += c; cnt += (c > 0u) ? 1u : 0u; mine = (j == x) ? c : mine; }
        if (sum == G) break;
        __builtin_amdgcn_s_sleep(1);
        if ((++sp & 255u) == 0u) { if (xb_ld(&bar[XB_TMO])) break; if (sp > XB_SPIN_CAP) { atomicAdd(&bar[XB_TMO], 1u); break; } }
    }
    nloc = mine > 0u ? mine : 1u; nx = cnt > 0u ? cnt : 1u;
}

__device__ __forceinline__ void xcd_barrier(const XcdBarrier& b) {
    asm volatile("s_waitcnt vmcnt(0)" ::: "memory");
    __syncthreads();
    if (threadIdx.x == 0) {
        unsigned* bar = b.bar;
        __builtin_amdgcn_s_waitcnt(0);
        unsigned nloc = b.st[0], nx = b.st[1];
        if (nloc == 0u) { xcd_barrier_complete(bar, b.x, nloc, nx); b.st[0] = nloc; b.st[1] = nx; }
        const unsigned old = xb_add(&bar[XB_XSUB(b.x)], 1u);
        const unsigned gen = old / nloc;
        if (old + 1u == (gen + 1u) * nloc) {
            __builtin_amdgcn_fence(__ATOMIC_RELEASE, "agent");
            asm volatile("s_waitcnt vmcnt(0)" ::: "memory");
            const unsigned og = xb_add(&bar[XB_TOP], 1u);
            const unsigned tg = og / nx;
            if (og + 1u == (tg + 1u) * nx) xb_add(&bar[XB_TOPGEN], 1u);
            else XB_SPIN(xb_ld(&bar[XB_TOPGEN]) == tg, bar);
            __builtin_amdgcn_fence(__ATOMIC_ACQUIRE, "agent");
            xb_add(&bar[XB_XGEN(b.x)], 1u);
            asm volatile("s_waitcnt vmcnt(0)" ::: "memory");
        } else {
            XB_SPIN(xb_ld(&bar[XB_XGEN(b.x)]) == gen, bar);
            __builtin_amdgcn_fence(__ATOMIC_ACQUIRE, "agent");
            asm volatile("s_waitcnt vmcnt(0)" ::: "memory");
        }
    }
    __syncthreads();
}

#define WSP(var) __attribute__((address_space(1))) unsigned char* var##_g = (__attribute__((address_space(1))) unsigned char*)a.ws; asm volatile("" : "+s"(var##_g)); unsigned char* var = (unsigned char*)var##_g
template <int LAYER> __device__ __forceinline__ void tail_phases(const Args& a, LAS unsigned char* lds, const XcdBarrier& bar, int G, int bx, int wid) {
    {
        WSP(ws);
        pg8::Gemm g{(const bf16_t*)(ws + WS_MIX), (const bf16_t*)(ws + (LAYER == 0 ? WS_WEO : WS_WOO)), MTOK, 1024, 1024}; pg8::StaticOrder S; S.init(MTOK, 1024, G, bx);
        EpiResid E{(const bf16_t*)(ws + WS_XB), nullptr, (bf16_t*)(ws + WS_XB), (float*)(ws + WS_SSQ) + (LAYER == 0 ? 1 : 3) * MTOK};
#ifndef NO_GR
        pg8::gemm_phase<EpiResid, pg8::StaticOrder, true, true>(lds, g, S, E, wid);
#endif
    }
    xcd_barrier(bar);
    {
        WSP(ws);
        pg8::Gemm g{(const bf16_t*)(ws + WS_XB), (const bf16_t*)(ws + (LAYER == 0 ? WS_WFI0 : WS_WFI1)), MTOK, 2 * DFF, 1024}; pg8::StaticOrder S; S.init(MTOK, 2 * DFF, G, bx);
        EpiSwiglu E{(const float*)(ws + WS_SSQ) + (LAYER == 0 ? 1 : 3) * MTOK, (bf16_t*)(ws + WS_ACT)};
#ifndef NO_GS
        pg8::gemm_phase<EpiSwiglu, pg8::StaticOrder, true, true>(lds, g, S, E, wid);
#endif
        if (LAYER == 0) { const int n6 = (MTOK / 256) * (2 * DFF / 256) - 5 * G;
            if (G == 256 && bx >= n6) convert_late(a, ws, lds, (bx - n6) * 8 + wid, (G - n6) * 8, wid);
            else if (G != 256 && bx == 0) convert_late(a, ws, lds, wid, 8, wid); }
    }
    xcd_barrier(bar);
    {
        WSP(ws);
        pg8::Gemm g{(const bf16_t*)(ws + WS_ACT), (const bf16_t*)(ws + (LAYER == 0 ? WS_WFO0 : WS_WFO1)), MTOK, 1024, DFF}; pg8::StaticOrder S; S.init(MTOK, 1024, G, bx);
        EpiResid E{(const bf16_t*)(ws + WS_XB), LAYER == 0 ? nullptr : a.out, LAYER == 0 ? (bf16_t*)(ws + WS_XB) : nullptr, LAYER == 0 ? (float*)(ws + WS_SSQ) + 2 * MTOK : nullptr};
#ifndef NO_GR
        pg8::gemm_phase<EpiResid, pg8::StaticOrder, true, true>(lds, g, S, E, wid);
#endif
    }
}

__global__ void __launch_bounds__(512, 2) mega_fwd(Args a) {
    extern __shared__ __attribute__((aligned(16))) unsigned char smem[];
    LAS unsigned char* lds = (LAS unsigned char*)smem;
    const int G = gridDim.x, bx = blockIdx.x, wid = __builtin_amdgcn_readfirstlane(threadIdx.x >> 6);
#define VCU ((G % 8 == 0) ? (bx % 8) * (G / 8) + bx / 8 : bx)
    if (threadIdx.x < 2) ((volatile LAS unsigned*)(lds + LDS_BYTES - 64))[threadIdx.x] = 0u;
    __syncthreads();
    const XcdBarrier bar = xcd_barrier_post((unsigned*)(a.ws + WS_BAR), (volatile LAS unsigned*)(lds + LDS_BYTES - 64));
#ifndef NO_PRO
    prologue(a, lds, VCU, G, wid);
#endif
    xcd_barrier(bar);
    {
        WSP(ws);
        pg8::Gemm g{(const bf16_t*)(ws + WS_XB), (const bf16_t*)(ws + WS_WEI), MTOK, 1024, 1024}; pg8::StaticOrder S; S.init(MTOK, 1024, G, bx); EpiDiffQK E{ws};
#ifndef NO_GEI
        pg8::gemm_phase<EpiDiffQK, pg8::StaticOrder, true, true>(lds, g, S, E, wid);
#endif
    }
    {
        WSP(ws);
        pg8::Gemm g{(const bf16_t*)(ws + WS_XB), (const bf16_t*)(ws + WS_WEI) + (size_t)1024 * 1024, MTOK, 1024, 1024}; pg8::StaticOrder S; S.init(MTOK, 1024, G, bx); EpiMobaQK E{ws};
#ifndef NO_GEI
        pg8::gemm_phase<EpiMobaQK, pg8::StaticOrder, true, true>(lds, g, S, E, wid);
#endif
    }
    {
        WSP(ws);
        pg8::Gemm g{(const bf16_t*)(ws + WS_XB), (const bf16_t*)(ws + WS_WEI) + (size_t)2048 * 1024, MTOK, 1024, 1024}; pg8::StaticOrder S; S.init(MTOK, 1024, G, bx); EpiV E{ws};
#ifndef NO_GEI
        pg8::gemm_phase<EpiV, pg8::StaticOrder, false, true>(lds, g, S, E, wid);
#endif
    }
    xcd_barrier(bar);
    {
        WSP(ws);
        for (int u = VCU; u < 256; u += G) {
            const int bh = u >> 3, s = u & 7, b = bh >> 3, hd = bh & 7;
#ifndef NO_AD
#pragma nounroll
            for (int k = 0; k < 2; ++k) attn_unit<true>(lds, ws, b, hd, k == 0 ? 15 - s : s, wid);
#endif
#ifndef NO_AM
#pragma nounroll
            for (int k = 0; k < 2; ++k) attn_unit<false>(lds, ws, b, hd, k == 0 ? 15 - s : s, wid);
#endif
        }
    }
    xcd_barrier(bar);
    tail_phases<0>(a, lds, bar, G, bx, wid);
    xcd_barrier(bar);
    {
        WSP(ws);
        pg8::Gemm g{(const bf16_t*)(ws + WS_XB), (const bf16_t*)(ws + WS_WOI), MTOK, 2048, 1024}; pg8::StaticOrder S; S.init(MTOK, 2048, G, bx); EpiOddIn E{ws};
#ifndef NO_GOI
        pg8::gemm_phase<EpiOddIn, pg8::StaticOrder, true, true>(lds, g, S, E, wid);
#endif
    }
    xcd_barrier(bar);
    {
        WSP(ws);
        for (int it = bx; it < 256 + 512; it += G) {
#ifndef NO_GM
            if (it >= 256) gmlp_item(lds, ws, it - 256, wid);
#endif
#ifndef NO_CV
            if (it < 256) conv_item(lds, ws, it, wid);
#endif
        }
    }
    xcd_barrier(bar);
    tail_phases<1>(a, lds, bar, G, bx, wid);
}

extern "C" void kernel_launch(void* const* d_in, const int* in_sizes, int n_in, void* d_out, int out_size, void* d_ws, size_t ws_size, hipStream_t stream) {
    static int grid = 0;
    if (grid == 0) {
        if (n_in != 27 || out_size != MTOK * DMODEL || ws_size < WS_END) { fprintf(stderr, "kernel_launch: unexpected shapes (n_in %d out %d ws %zu)\n", n_in, out_size, ws_size); grid = -1; return; }
        int dev = 0, cus = 0, per_cu = 0;
        hipGetDevice(&dev); hipDeviceGetAttribute(&cus, hipDeviceAttributeMultiprocessorCount, dev);
        hipFuncSetAttribute((const void*)mega_fwd, hipFuncAttributeMaxDynamicSharedMemorySize, LDS_BYTES);
        hipOccupancyMaxActiveBlocksPerMultiprocessor(&per_cu, (const void*)mega_fwd, 512, LDS_BYTES);
        if (per_cu < 1) { fprintf(stderr, "kernel_launch: occupancy query says %d blocks/CU\n", per_cu); per_cu = 1; }
        (void)hipGetLastError();
        grid = cus;
    }
    if (grid < 0) return;
    if (hipMemsetAsync((char*)d_ws + WS_BAR, 0, 3456 * 4, stream) != hipSuccess) { fprintf(stderr, "kernel_launch: memset of the barrier words failed\n"); return; }
    Args a{};
    for (int i = 0; i < 27; ++i) a.in[i] = (const float*)d_in[i];
    a.out = (float*)d_out; a.ws = (unsigned char*)d_ws;
    void* args[] = {&a};
    hipError_t e = hipLaunchCooperativeKernel((const void*)mega_fwd, dim3(grid), dim3(512), args, LDS_BYTES, stream);
    if (e != hipSuccess) fprintf(stderr, "cooperative launch failed: %s (grid %d)\n", hipGetErrorString(e), grid);
}
```

```cpp
#include <hip/hip_runtime.h>
#include <hip/hip_cooperative_groups.h>
#include <hip/hip_bf16.h>
#include <cstdio>
#include <cstdint>
namespace cg = cooperative_groups;
namespace pg8 {
#define PG8_LAS __attribute__((address_space(3)))
typedef unsigned short bf16_t;
typedef short bf16x8 __attribute__((ext_vector_type(8)));
typedef float f32x4 __attribute__((ext_vector_type(4)));
typedef unsigned u32x4 __attribute__((ext_vector_type(4)));
constexpr int BM = 256, BK = 64, HALF = 128, HTB = HALF * BK * 2  , STAGE_BYTES = 8 * HTB, NXCD = 8, WGM = 8;

__host__ __device__ __forceinline__ int lds_byte(int r, int c) { const int st = (r >> 4) * 2 + (c >> 5), rr = r & 15, cc = c & 31, ob = rr * 64 + cc * 2; return st * 1024 + (ob ^ (((ob >> 9) & 1) << 5)); }
__host__ __device__ __forceinline__ void stage_rc(int b, int& R, int& C) { const int st = b / 1024, sb = b % 1024, swz = sb ^ (((sb >> 9) & 1) << 5); R = (st >> 1) * 16 + swz / 64; C = (st & 1) * 32 + (swz % 64) / 2; }
__host__ __device__ __forceinline__ int perm32(int rho) { const int n = rho >> 4, i = rho & 15; return 8 * (i >> 2) + 4 * n + (i & 3); }

struct Unit { int pm, pn; };
struct Gemm { const bf16_t* A; const bf16_t* Bt; int M, N, K; };

struct StaticOrder {
    int nM, nN, nwg, G, c;
    __host__ __device__ void init(int M, int N, int G_, int c_) { nM = M / BM; nN = N / BM; nwg = nM * nN; G = G_; c = c_; }
    __host__ __device__ bool next(int i, Unit& u) const {
        const long L = (long)i * G + c; if (L >= nwg) return false;
        int wgid = (int)L; { const int q = nwg / NXCD, r = nwg % NXCD, xcd = wgid % NXCD, off = wgid / NXCD; wgid = (xcd < r ? xcd * (q + 1) : r * (q + 1) + (xcd - r) * q) + off; }
        const int nig = WGM * nN, gid = wgid / nig, fm = gid * WGM, gsz = (nM - fm) < WGM ? (nM - fm) : WGM;
        u.pm = fm + ((wgid % nig) % gsz); u.pn = (wgid % nig) / gsz; return true;
    }
    __device__ __forceinline__ void a_ready(const Unit&) const {}
    __device__ __forceinline__ void done(const Unit&) const {}
};

__device__ __forceinline__ unsigned cvt_pk_bf16(float lo, float hi) { unsigned r; asm volatile("v_cvt_pk_bf16_f32 %0, %1, %2" : "=v"(r) : "v"(lo), "v"(hi)); return r; }
typedef float f32x2 __attribute__((ext_vector_type(2)));
__device__ __forceinline__ f32x2 gelu_pk(f32x2 v) {
    const f32x2 av = __builtin_elementwise_abs(v), d = av * 0.2316418882f + 1.0f;
    f32x2 t; t.x = __builtin_amdgcn_rcpf(d.x); t.y = __builtin_amdgcn_rcpf(d.y);
    f32x2 q = t * 0.5307027145f + (-0.7265760135f); q = q * t + 0.7107068705f; q = q * t + (-0.142248368f); q = q * t + 0.127414796f; q = q * t;
    const f32x2 s = (v * v) * (-0.72134752044f);
    f32x2 e; e.x = __builtin_amdgcn_exp2f(s.x); e.y = __builtin_amdgcn_exp2f(s.y);
    const f32x2 m = v * (q * e), r = v - m;
    f32x2 o; o.x = v.x < 0.f ? m.x : r.x; o.y = v.y < 0.f ? m.y : r.y; return o;
}

template <int ACT  > struct EpiBf16 {
    static constexpr bool PERM = true, AFTER_DRAIN = false; static_assert(ACT == 0 || ACT == 1, "EpiBf16: ACT is 0 (none) or 1 (gelu_pk)");
    bf16_t* O; int ldc; const float* bias; int split_cols; size_t split_stride; float scale0;
    __device__ __forceinline__ void operator()(const f32x4 (&acc)[2][2][4][2], const Unit& u, int wr, int wc, int fr, int fq) const {
        const int row0 = u.pm * BM + wr * 64 + fr; int colt = u.pn * BM; bf16_t* base = O;
        float sc = 1.f; if (split_cols) { const int t = colt / split_cols; base += (size_t)t * split_stride; colt -= t * split_cols; if (t == 0) sc = scale0; }
        const int col0 = colt + wc * 32 + 8 * fq, bcol0 = u.pn * BM + wc * 32 + 8 * fq;
        f32x4 bv[2][2];
#pragma unroll
        for (int bj = 0; bj < 2; ++bj)
#pragma unroll
            for (int n = 0; n < 2; ++n) bv[bj][n] = bias ? *(const f32x4*)(bias + bcol0 + bj * HALF + 4 * n) : (f32x4){0.f, 0.f, 0.f, 0.f};
#pragma unroll
        for (int ai = 0; ai < 2; ++ai)
#pragma unroll
            for (int m = 0; m < 4; ++m) { bf16_t* rowp = base + (size_t)(row0 + ai * HALF + m * 16) * ldc + col0;
#pragma unroll
                for (int bj = 0; bj < 2; ++bj) { f32x4 v0 = acc[ai][bj][m][0] + bv[bj][0], v1 = acc[ai][bj][m][1] + bv[bj][1];
                    if (ACT == 1) { f32x2 a = gelu_pk((f32x2){v0[0], v0[1]}), b = gelu_pk((f32x2){v0[2], v0[3]}), c = gelu_pk((f32x2){v1[0], v1[1]}), d = gelu_pk((f32x2){v1[2], v1[3]});
                        v0 = (f32x4){a.x, a.y, b.x, b.y}; v1 = (f32x4){c.x, c.y, d.x, d.y}; }
                    v0 = v0 * sc; v1 = v1 * sc; u32x4 w; w.x = cvt_pk_bf16(v0[0], v0[1]); w.y = cvt_pk_bf16(v0[2], v0[3]); w.z = cvt_pk_bf16(v1[0], v1[1]); w.w = cvt_pk_bf16(v1[2], v1[3]);
                    *(u32x4*)(rowp + bj * HALF) = w; } }
    }
};

struct PanelStats {
    unsigned* xbuf;
    unsigned* cnt;
    unsigned* tmo;
    int ntn; float eps;
    unsigned code;
    __device__ __forceinline__ bool run(const f32x4 (&v)[2][2][4][2], const Unit& u, int wr, int wc, int fr, int fq, PG8_LAS unsigned char* lds, int wid, int lane) const {
        typedef float f32x2v __attribute__((ext_vector_type(2)));
        PG8_LAS f32x2v* P = (PG8_LAS f32x2v*)lds;
        PG8_LAS f32x2v* S = (PG8_LAS f32x2v*)(lds + 8192);
        PG8_LAS unsigned* flag = (PG8_LAS unsigned*)(lds + 8192 + 2048);
#pragma unroll
        for (int ai = 0; ai < 2; ++ai)
#pragma unroll
            for (int m = 0; m < 4; ++m) {
                float s = 0.f;
#pragma unroll
                for (int bj = 0; bj < 2; ++bj)
#pragma unroll
                    for (int n = 0; n < 2; ++n) { const f32x4 x = v[ai][bj][m][n]; s += (x[0] + x[1]) + (x[2] + x[3]); }
                s += __shfl_xor(s, 16); s += __shfl_xor(s, 32);
                const float mw = s * (1.0f / 64.0f); float q = 0.f;
#pragma unroll
                for (int bj = 0; bj < 2; ++bj)
#pragma unroll
                    for (int n = 0; n < 2; ++n) { const f32x4 d = v[ai][bj][m][n] - mw; q += (d[0] * d[0] + d[1] * d[1]) + (d[2] * d[2] + d[3] * d[3]); }
                q += __shfl_xor(q, 16); q += __shfl_xor(q, 32);
                if (fq == 0) P[(ai * HALF + wr * 64 + m * 16 + fr) * 4 + wc] = (f32x2v){mw, q};
            }
        asm volatile("s_waitcnt lgkmcnt(0)" ::: "memory"); __builtin_amdgcn_s_barrier(); asm volatile("" ::: "memory");
#if defined(BROKEN_EXCHANGE_NO_WAIT)
#warning BROKEN CONTROL BUILD: the row-statistics exchange does not wait; results are wrong by design
        if (blockIdx.x >= 64) { const long long t0_ = clock64(); while (clock64() - t0_ < 60000) __builtin_amdgcn_s_sleep(8); }
#endif
        const int row = wid * 32 + (lane & 31);
        if (lane < 32) {
            const f32x2v a = P[row * 4 + 0], b = P[row * 4 + 1], c = P[row * 4 + 2], d = P[row * 4 + 3];
            const float mt = (a.x + b.x + c.x + d.x) * 0.25f;
            const float da = a.x - mt, db = b.x - mt, dc = c.x - mt, dd = d.x - mt;
            const float m2 = (a.y + b.y) + (c.y + d.y) + 64.0f * ((da * da + db * db) + (dc * dc + dd * dd));
            unsigned long long* slot = (unsigned long long*)xbuf + ((size_t)(u.pm * BM + row) * 4 + u.pn);
            __hip_atomic_store(slot, ((unsigned long long)__float_as_uint(m2) << 32) | __float_as_uint(mt), __ATOMIC_RELAXED, __HIP_MEMORY_SCOPE_AGENT);
        }
        asm volatile("s_waitcnt vmcnt(0)" ::: "memory");
        if (lane == 0) __hip_atomic_fetch_add(cnt + 64 * u.pm, 1u, __ATOMIC_RELAXED, __HIP_MEMORY_SCOPE_AGENT);
        if (wid == 0) {
            bool dead = false; const unsigned long long t0 = __builtin_amdgcn_s_memrealtime(); const unsigned want = 8u * (unsigned)ntn;
            for (;;) {
#if defined(BROKEN_EXCHANGE_NO_WAIT)
                break;
#endif
                if ((unsigned)__builtin_amdgcn_readfirstlane(__hip_atomic_load(cnt + 64 * u.pm, __ATOMIC_RELAXED, __HIP_MEMORY_SCOPE_AGENT)) >= want) break;
                if (__builtin_amdgcn_s_memrealtime() - t0 > 2000000ull) {
                    if (lane == 0) { unsigned expect = 0u; __hip_atomic_compare_exchange_strong(tmo + 1, &expect, code | (unsigned)(u.pm & 0xff), __ATOMIC_RELAXED, __ATOMIC_RELAXED, __HIP_MEMORY_SCOPE_AGENT);
                                     __hip_atomic_store(tmo, 1u, __ATOMIC_RELAXED, __HIP_MEMORY_SCOPE_AGENT); }
                    dead = true; break; }
                __builtin_amdgcn_s_sleep(2);
            }
            __builtin_amdgcn_fence(__ATOMIC_ACQUIRE, "agent");
            if (lane == 0) flag[0] = dead ? 1u : 0u;
        }
        asm volatile("s_waitcnt vmcnt(0) lgkmcnt(0)" ::: "memory"); __builtin_amdgcn_s_barrier(); asm volatile("" ::: "memory");
        const bool bad = flag[0] != 0u;
        if (lane < 32) {
            const unsigned long long* slot = (const unsigned long long*)xbuf + (size_t)(u.pm * BM + row) * 4; float mt[4], m2[4]; float ms = 0.f;
#pragma unroll
            for (int t = 0; t < 4; ++t) { if (t < ntn) { const unsigned long long w = __hip_atomic_load(slot + t, __ATOMIC_RELAXED, __HIP_MEMORY_SCOPE_AGENT); mt[t] = __uint_as_float((unsigned)w); m2[t] = __uint_as_float((unsigned)(w >> 32)); } else { mt[t] = 0.f; m2[t] = 0.f; } ms += mt[t]; }
            const float mean = ms / (float)ntn; float q = 0.f;
#pragma unroll
            for (int t = 0; t < 4; ++t) if (t < ntn) { const float dm = mt[t] - mean; q += m2[t] + 256.0f * dm * dm; }
            S[row] = (f32x2v){mean, 1.0f / sqrtf(q / (256.0f * (float)ntn) + eps)};
        }
        asm volatile("s_waitcnt lgkmcnt(0)" ::: "memory"); __builtin_amdgcn_s_barrier(); asm volatile("" ::: "memory");
        return bad;
    }
};
struct EpiLnRes {
    static constexpr bool PERM = false, AFTER_DRAIN = true;
    const float* base; float* out; int ldc; const float* bias; PanelStats st; unsigned poison;
    __device__ __forceinline__ void fused(f32x4 (&acc)[2][2][4][2], const Unit& u, int wr, int wc, int fr, int fq, PG8_LAS unsigned char* lds, int wid, int lane) const {
        typedef float f32x2v __attribute__((ext_vector_type(2)));
        const PG8_LAS f32x2v* S = (const PG8_LAS f32x2v*)(lds + 8192);
        const int col0 = u.pn * BM + wc * 32 + 4 * fq;
#pragma unroll
        for (int bj = 0; bj < 2; ++bj)
#pragma unroll
            for (int n = 0; n < 2; ++n) { const f32x4 bv = bias ? *(const f32x4*)(bias + col0 + bj * HALF + n * 16) : (f32x4){0.f, 0.f, 0.f, 0.f};
#pragma unroll
                for (int ai = 0; ai < 2; ++ai)
#pragma unroll
                    for (int m = 0; m < 4; ++m) acc[ai][bj][m][n] += bv; }
        f32x4 pre[4][2][2];
#pragma unroll
        for (int m = 0; m < 4; ++m) { const size_t off = (size_t)(u.pm * BM + wr * 64 + m * 16 + fr) * ldc + col0;
#pragma unroll
            for (int bj = 0; bj < 2; ++bj)
#pragma unroll
                for (int n = 0; n < 2; ++n) pre[m][bj][n] = *(const f32x4*)(base + off + bj * HALF + n * 16); }
        const bool bad = st.run(acc, u, wr, wc, fr, fq, lds, wid, lane) || poison != 0u;
        const float qnan = __builtin_nanf("");
#pragma unroll
        for (int ai = 0; ai < 2; ++ai)
#pragma unroll
            for (int m = 0; m < 4; ++m) { const int r = ai * HALF + wr * 64 + m * 16 + fr; const f32x2v sr = S[r]; const size_t off = (size_t)(u.pm * BM + r) * ldc + col0;
#pragma unroll
                for (int bj = 0; bj < 2; ++bj)
#pragma unroll
                    for (int n = 0; n < 2; ++n) { const f32x4 bs = ai == 0 ? pre[m][bj][n] : *(const f32x4*)(base + off + bj * HALF + n * 16); f32x4 o = bs + (acc[ai][bj][m][n] - sr.x) * sr.y;
                        if (bad) o = (f32x4){qnan, qnan, qnan, qnan}; *(f32x4*)(out + off + bj * HALF + n * 16) = o; }
                if (m & 1) asm volatile("" ::: "memory"); }
    }
};
struct EpiLnResLn {
    static constexpr bool PERM = false, AFTER_DRAIN = true;
    const float* base; float* out; bf16_t* xn; int ldc; const float* bias; PanelStats st1, st2; unsigned poison;
    __device__ __forceinline__ void fused(f32x4 (&acc)[2][2][4][2], const Unit& u, int wr, int wc, int fr, int fq, PG8_LAS unsigned char* lds, int wid, int lane) const {
        typedef float f32x2v __attribute__((ext_vector_type(2))); typedef unsigned u32x2v __attribute__((ext_vector_type(2)));
        const PG8_LAS f32x2v* S = (const PG8_LAS f32x2v*)(lds + 8192);
        const int col0 = u.pn * BM + wc * 32 + 4 * fq;
#pragma unroll
        for (int bj = 0; bj < 2; ++bj)
#pragma unroll
            for (int n = 0; n < 2; ++n) { const f32x4 bv = bias ? *(const f32x4*)(bias + col0 + bj * HALF + n * 16) : (f32x4){0.f, 0.f, 0.f, 0.f};
#pragma unroll
                for (int ai = 0; ai < 2; ++ai)
#pragma unroll
                    for (int m = 0; m < 4; ++m) acc[ai][bj][m][n] += bv; }
        bool bad = st1.run(acc, u, wr, wc, fr, fq, lds, wid, lane) || poison != 0u;
        const float qnan = __builtin_nanf("");
#pragma unroll
        for (int ai = 0; ai < 2; ++ai)
#pragma unroll
            for (int m = 0; m < 4; ++m) { const int r = ai * HALF + wr * 64 + m * 16 + fr; const f32x2v sr = S[r]; const size_t off = (size_t)(u.pm * BM + r) * ldc + col0;
#pragma unroll
                for (int bj = 0; bj < 2; ++bj)
#pragma unroll
                    for (int n = 0; n < 2; ++n) { const f32x4 bs = *(const f32x4*)(base + off + bj * HALF + n * 16); acc[ai][bj][m][n] = bs + (acc[ai][bj][m][n] - sr.x) * sr.y; }
                asm volatile("" : "+v"(acc[ai][0][m][0]), "+v"(acc[ai][0][m][1]), "+v"(acc[ai][1][m][0]), "+v"(acc[ai][1][m][1]));
                if (m & 1) asm volatile("" ::: "memory"); }
        const bool bad1 = bad;
        bad = st2.run(acc, u, wr, wc, fr, fq, lds, wid, lane) || bad;
#pragma unroll
        for (int ai = 0; ai < 2; ++ai)
#pragma unroll
            for (int m = 0; m < 4; ++m) { const int r = ai * HALF + wr * 64 + m * 16 + fr; const f32x2v sr = S[r]; const size_t off = (size_t)(u.pm * BM + r) * ldc + col0;
#pragma unroll
                for (int bj = 0; bj < 2; ++bj)
#pragma unroll
                    for (int n = 0; n < 2; ++n) { const f32x4 x1 = acc[ai][bj][m][n]; *(f32x4*)(out + off + bj * HALF + n * 16) = bad1 ? (f32x4){qnan, qnan, qnan, qnan} : x1;
                        const f32x4 o = (x1 - sr.x) * sr.y; u32x2v w; w.x = cvt_pk_bf16(o[0], o[1]); w.y = cvt_pk_bf16(o[2], o[3]);
                        if (bad) { w.x = 0x7fc07fc0u; w.y = 0x7fc07fc0u; } *(u32x2v*)(xn + off + bj * HALF + n * 16) = w; }
                asm volatile("" ::: "memory"); }
    }
};

template <class Epi, class Sched, bool ALIGN_EPI = false, bool SP2 = false>
__device__ __forceinline__ void gemm_phase(PG8_LAS unsigned char* lds, const Gemm g, const Sched& S, const Epi& E, int wid_s) {
    int lane_; asm volatile("v_mbcnt_lo_u32_b32 %0, -1, 0\n\tv_mbcnt_hi_u32_b32 %0, -1, %0" : "=v"(lane_));
    const int tid = wid_s * 64 + lane_, wid = wid_s, lane = tid & 63, wr = wid >> 2, wc = wid & 3, fr = lane & 15, fq = lane >> 4;
    const int K = g.K, nt = K / BK;
    unsigned voffA[2], voffB[2];
#pragma unroll
    for (int i = 0; i < 2; ++i) { int R, C; stage_rc(tid * 16 + i * 8192, R, C); const int Rb = Epi::PERM ? ((R & ~31) + perm32(R & 31)) : R;
        voffA[i] = (unsigned)(R * K + C) * 2u; voffB[i] = (unsigned)(Rb * K + C) * 2u; }
    const size_t kstep = (size_t)(BK * 2);
    const size_t hstep = (size_t)HALF * K * 2;
    const size_t tstep = 2 * hstep;
    const unsigned ldsw = (unsigned)wid * 1024u;
    const int aoff = lds_byte(wr * 64 + fr, fq * 8), boff = lds_byte(wc * 32 + fr, fq * 8);
#define PG8_SA(b, h) (((b) * 2 + (h)) * HTB)
#define PG8_SB(b, h) ((4 + (b) * 2 + (h)) * HTB)
#define PG8_STAGE(bufoff, gbase, voff) do { _Pragma("unroll") for (int _i = 0; _i < 2; ++_i) \
        __builtin_amdgcn_global_load_lds((const unsigned*)((const char*)(gbase) + (voff)[_i]), (PG8_LAS unsigned*)(lds + (bufoff) + ldsw + _i * 8192), 16, 0, 0); } while (0)
#define PG8_LDA(dst, b, h) do { _Pragma("unroll") for (int m = 0; m < 4; ++m) _Pragma("unroll") for (int k = 0; k < 2; ++k) dst[m][k] = *(const PG8_LAS bf16x8*)(lds + PG8_SA(b, h) + aoff + m * 2048 + k * 1024); } while (0)
#define PG8_LDB(dst, b, h) do { _Pragma("unroll") for (int n = 0; n < 2; ++n) _Pragma("unroll") for (int k = 0; k < 2; ++k) dst[n][k] = *(const PG8_LAS bf16x8*)(lds + PG8_SB(b, h) + boff + n * 2048 + k * 1024); } while (0)
#define PG8_MMA(ai, bj, At, Bt) do { __builtin_amdgcn_s_setprio(1); _Pragma("unroll") for (int m = 0; m < 4; ++m) _Pragma("unroll") for (int n = 0; n < 2; ++n) _Pragma("unroll") for (int k = 0; k < 2; ++k) \
        acc[ai][bj][m][n] = __builtin_amdgcn_mfma_f32_16x16x32_bf16(Bt[n][k], At[m][k], acc[ai][bj][m][n], 0, 0, 0); __builtin_amdgcn_s_setprio(0); } while (0)
#define PG8_WAIT_V(n) asm volatile("s_waitcnt vmcnt(" #n ")" ::: "memory")
#define PG8_WAIT_L(n) asm volatile("s_waitcnt lgkmcnt(" #n ")" ::: "memory")
#define PG8_BAR __builtin_amdgcn_s_barrier()
#define PG8_SCHED __builtin_amdgcn_sched_barrier(0)
    Unit cur, nxt; int ui = 0;
    if (!S.next(0, cur)) return;
    f32x4 acc[2][2][4][2];
#pragma unroll
    for (int a = 0; a < 2; ++a)
#pragma unroll
        for (int b = 0; b < 2; ++b)
#pragma unroll
            for (int m = 0; m < 4; ++m)
#pragma unroll
                for (int n = 0; n < 2; ++n) acc[a][b][m][n] = (f32x4){0.f, 0.f, 0.f, 0.f};
    bf16x8 At[4][2], B0[2][2], B1[2][2];
    const char* cA = (const char*)g.A + (size_t)cur.pm * tstep; const char* cB = (const char*)g.Bt + (size_t)cur.pn * tstep;
    S.a_ready(cur);
    if constexpr (SP2) {
        PG8_STAGE(PG8_SB(0, 0), cB, voffB); PG8_STAGE(PG8_SB(0, 1), cB + hstep, voffB); PG8_STAGE(PG8_SA(0, 0), cA, voffA); PG8_STAGE(PG8_SA(0, 1), cA + hstep, voffA);
        if (wr == 1) PG8_BAR;
        PG8_WAIT_V(2); PG8_BAR;
        PG8_STAGE(PG8_SB(1, 0), cB + kstep, voffB); PG8_STAGE(PG8_SA(1, 0), cA + kstep, voffA); PG8_STAGE(PG8_SB(1, 1), cB + hstep + kstep, voffB);
        PG8_WAIT_V(6); PG8_BAR;
    } else {
        PG8_STAGE(PG8_SB(0, 0), cB, voffB); PG8_STAGE(PG8_SA(0, 0), cA, voffA); PG8_STAGE(PG8_SB(0, 1), cB + hstep, voffB); PG8_STAGE(PG8_SA(0, 1), cA + hstep, voffA);
        if (wr == 1) PG8_BAR;
        PG8_WAIT_V(4); PG8_BAR;
        PG8_STAGE(PG8_SB(1, 0), cB + kstep, voffB); PG8_STAGE(PG8_SA(1, 0), cA + kstep, voffA); PG8_STAGE(PG8_SB(1, 1), cB + hstep + kstep, voffB);
        PG8_WAIT_V(6); PG8_BAR;
    }
    for (;;) {
        const bool has_next = S.next(ui + 1, nxt);
        const char* nA = has_next ? (const char*)g.A + (size_t)nxt.pm * tstep : cA; const char* nB = has_next ? (const char*)g.Bt + (size_t)nxt.pn * tstep : cB;
        for (int t = 0; t < nt; t += 2) {
            const bool last = (t == nt - 2);
            const char* a1 = cA + (size_t)(t + 1) * kstep;
            const char* a2 = last ? nA : cA + (size_t)(t + 2) * kstep; const char* b2 = last ? nB : cB + (size_t)(t + 2) * kstep;
            const char* a3 = a2 + kstep; const char* b3 = b2 + kstep;
            if (last && has_next) S.a_ready(nxt);
            if constexpr (SP2) {
            PG8_LDB(B0, 0, 0); PG8_LDB(B1, 0, 1); PG8_SCHED; PG8_LDA(At, 0, 0); PG8_STAGE(PG8_SA(1, 1), a1 + hstep, voffA);
            PG8_WAIT_V(8); PG8_WAIT_L(0); PG8_BAR; PG8_MMA(0, 0, At, B0); PG8_MMA(0, 1, At, B1); PG8_BAR; PG8_SCHED;
            PG8_LDA(At, 0, 1); PG8_STAGE(PG8_SB(0, 0), b2, voffB); PG8_STAGE(PG8_SB(0, 1), b2 + hstep, voffB); PG8_STAGE(PG8_SA(0, 0), a2, voffA);
            PG8_WAIT_V(8); PG8_WAIT_L(0); PG8_BAR; PG8_MMA(1, 0, At, B0); PG8_MMA(1, 1, At, B1); PG8_BAR; PG8_SCHED;
            PG8_LDB(B0, 1, 0); PG8_LDB(B1, 1, 1); PG8_SCHED; PG8_LDA(At, 1, 0); PG8_STAGE(PG8_SA(0, 1), a2 + hstep, voffA);
            PG8_WAIT_V(8); PG8_WAIT_L(0); PG8_BAR; PG8_MMA(0, 0, At, B0); PG8_MMA(0, 1, At, B1); PG8_BAR; PG8_SCHED;
            PG8_LDA(At, 1, 1); PG8_STAGE(PG8_SB(1, 0), b3, voffB); PG8_STAGE(PG8_SB(1, 1), b3 + hstep, voffB); PG8_STAGE(PG8_SA(1, 0), a3, voffA);
            PG8_WAIT_V(8); PG8_WAIT_L(0); PG8_BAR; PG8_MMA(1, 0, At, B0); PG8_MMA(1, 1, At, B1); PG8_BAR; PG8_SCHED;
            } else {
            PG8_LDB(B0, 0, 0); PG8_SCHED; PG8_LDA(At, 0, 0); PG8_STAGE(PG8_SA(1, 1), a1 + hstep, voffA);
            PG8_WAIT_L(8); PG8_BAR; PG8_WAIT_L(0); PG8_MMA(0, 0, At, B0); PG8_BAR; PG8_SCHED;
            PG8_LDB(B1, 0, 1); PG8_STAGE(PG8_SB(0, 0), b2, voffB);
            PG8_BAR; PG8_WAIT_L(0); PG8_MMA(0, 1, At, B1); PG8_BAR;
            PG8_LDA(At, 0, 1); PG8_STAGE(PG8_SA(0, 0), a2, voffA);
            PG8_BAR; PG8_WAIT_L(0); PG8_MMA(1, 0, At, B0); PG8_BAR; PG8_SCHED;
            PG8_STAGE(PG8_SB(0, 1), b2 + hstep, voffB);
            PG8_WAIT_V(6); PG8_BAR; PG8_MMA(1, 1, At, B1); PG8_BAR;
            PG8_LDB(B0, 1, 0); PG8_SCHED; PG8_LDA(At, 1, 0); PG8_STAGE(PG8_SA(0, 1), a2 + hstep, voffA);
            PG8_WAIT_L(8); PG8_BAR; PG8_WAIT_L(0); PG8_MMA(0, 0, At, B0); PG8_BAR; PG8_SCHED;
            PG8_LDB(B1, 1, 1); PG8_STAGE(PG8_SB(1, 0), b3, voffB);
            PG8_BAR; PG8_WAIT_L(0); PG8_MMA(0, 1, At, B1); PG8_BAR;
            PG8_LDA(At, 1, 1); PG8_STAGE(PG8_SA(1, 0), a3, voffA);
            PG8_BAR; PG8_WAIT_L(0); PG8_MMA(1, 0, At, B0); PG8_BAR; PG8_SCHED;
            PG8_STAGE(PG8_SB(1, 1), b3 + hstep, voffB);
            PG8_WAIT_V(6); PG8_BAR; PG8_MMA(1, 1, At, B1); PG8_BAR;
            }
        }
        if constexpr (ALIGN_EPI) { if (wr == 0) PG8_BAR; }
        if constexpr (!Epi::AFTER_DRAIN) { E(acc, cur, wr, wc, fr, fq); S.done(cur); }
        if (!has_next) break;
#pragma unroll
        for (int a = 0; a < 2; ++a)
#pragma unroll
            for (int b = 0; b < 2; ++b)
#pragma unroll
                for (int m = 0; m < 4; ++m)
#pragma unroll
                    for (int n = 0; n < 2; ++n) acc[a][b][m][n] = (f32x4){0.f, 0.f, 0.f, 0.f};
        cur = nxt; cA = nA; cB = nB; ++ui;
        if constexpr (ALIGN_EPI) { if (wr == 1) PG8_BAR; }
    }
    PG8_WAIT_V(0);
    if constexpr (!ALIGN_EPI) { if (wr == 0) PG8_BAR; }
    PG8_BAR;
    if constexpr (Epi::AFTER_DRAIN) { E.fused(acc, cur, wr, wc, fr, fq, lds, wid, lane); S.done(cur); }
#undef PG8_SA
#undef PG8_SB
#undef PG8_STAGE
#undef PG8_LDA
#undef PG8_LDB
#undef PG8_MMA
#undef PG8_WAIT_V
#undef PG8_WAIT_L
#undef PG8_BAR
#undef PG8_SCHED
}
}

#define LAS __attribute__((address_space(3)))
typedef unsigned short bf16_t;
typedef short bf16x8 __attribute__((ext_vector_type(8)));
typedef short s16x4 __attribute__((ext_vector_type(4)));
typedef float f32x4 __attribute__((ext_vector_type(4)));
typedef float f32x16 __attribute__((ext_vector_type(16)));
typedef unsigned u32x4 __attribute__((ext_vector_type(4)));
typedef unsigned u32x2 __attribute__((ext_vector_type(2)));
typedef float f32x2_t __attribute__((ext_vector_type(2)));
typedef __bf16 bf16x2_t __attribute__((ext_vector_type(2)));

constexpr int MTOK = 16384, DMODEL = 1024, SEQL = 4096, DFF = 2816;
constexpr float EPS = 1e-6f;
constexpr float QSCALE_D = 0.17677669529663687f * 1.4426950408889634f;
constexpr float QSCALE_M = 0.125f * 1.4426950408889634f;
constexpr int LDS_BYTES = 147456;

constexpr size_t KiB = 1024, MiB = 1u << 20;
constexpr size_t WS_SSQ = 0, WS_GVST = 256 * KiB, WS_KBAR = 384 * KiB, WS_PAR = 512 * KiB, WS_BAR = 768 * KiB;
constexpr size_t WS_COS32 = 1 * MiB, WS_SIN32 = 1 * MiB + 256 * KiB, WS_COS64 = 2 * MiB, WS_SIN64 = 2 * MiB + 512 * KiB, WS_WSB = 3 * MiB;
constexpr size_t WS_WEI = 4 * MiB, WS_WEO = 10 * MiB, WS_WFI0 = 12 * MiB, WS_WFI1 = 23 * MiB, WS_WFO0 = 34 * MiB, WS_WFO1 = 34 * MiB + 5632 * KiB;
constexpr size_t WS_WOI = 45 * MiB, WS_WOO = 49 * MiB, WS_XB = 52 * MiB, WS_MIX = 84 * MiB, WS_BIG = 116 * MiB;
constexpr size_t WS_QK = WS_BIG, WS_VT = WS_BIG + 64 * MiB, WS_ACT = WS_BIG, WS_GU = WS_BIG, WS_GV = WS_BIG + 16 * MiB, WS_CP = WS_BIG + 32 * MiB;
constexpr size_t WS_END = 212 * MiB;

struct Args { const float* in[27]; float* out; unsigned char* ws; };

__device__ __forceinline__ unsigned cvtpk(float lo, float hi) { f32x2_t v = {lo, hi}; bf16x2_t b = __builtin_convertvector(v, bf16x2_t); return __builtin_bit_cast(unsigned, b); }
__device__ __forceinline__ bf16_t f2bf(float f) { return (bf16_t)(cvtpk(f, 0.f) & 0xffffu); }
__device__ __forceinline__ float bf2f(bf16_t u) { return __uint_as_float((unsigned)u << 16); }
__device__ __forceinline__ float bflo(unsigned w) { return __uint_as_float(w << 16); }
__device__ __forceinline__ float bfhi(unsigned w) { return __uint_as_float(w & 0xffff0000u); }
__device__ __forceinline__ float dot4(f32x4 a) { return (a[0] * a[0] + a[1] * a[1]) + (a[2] * a[2] + a[3] * a[3]); }
__device__ __forceinline__ float sum4(f32x4 a) { return (a[0] + a[1]) + (a[2] + a[3]); }
__device__ __forceinline__ u32x2 pk4(f32x4 v) { u32x2 w; w.x = cvtpk(v[0], v[1]); w.y = cvtpk(v[2], v[3]); return w; }
__device__ __forceinline__ float wave_sum(float v) {
#pragma unroll
    for (int o = 1; o < 64; o <<= 1) v += __shfl_xor(v, o);
    return v;
}
__device__ __forceinline__ float hswap_max(float v) { auto rr = __builtin_amdgcn_permlane32_swap(__float_as_uint(v), __float_as_uint(v), false, false); return fmaxf(__uint_as_float(rr[0]), __uint_as_float(rr[1])); }
__device__ __forceinline__ float hswap_sum(float v) { auto rr = __builtin_amdgcn_permlane32_swap(__float_as_uint(v), __float_as_uint(v), false, false); return __uint_as_float(rr[0]) + __uint_as_float(rr[1]); }
__device__ __forceinline__ float fast_sigmoid(float x) { return __builtin_amdgcn_rcpf(1.f + __expf(-x)); }
#define MFMA32(a, b, c) __builtin_amdgcn_mfma_f32_32x32x16_bf16((a), (b), (c), 0, 0, 0)
__device__ __forceinline__ int mk_tid(int wid_s) { int lane_; asm volatile("v_mbcnt_lo_u32_b32 %0, -1, 0\n\tv_mbcnt_hi_u32_b32 %0, -1, %0" : "=v"(lane_)); return wid_s * 64 + lane_; }
__device__ __forceinline__ int crow(int reg, int h) { return (reg & 3) + 8 * (reg >> 2) + 4 * h; }


constexpr int PB_QN = 0, PB_KN = 32, PB_MQN = 64, PB_MKN = 128, PB_SUBLN = 192, PB_OBIAS = 256, PB_GLNG = 2304, PB_GLNB = 2816, PB_GBS = 3328, PB_CW = 4352, PB_CB = 20224, PB_CLNG = 20736, PB_CLNB = 21248, PB_LAM = 21760;
struct EpiDiffQK {
    static constexpr bool PERM = false, AFTER_DRAIN = false;
    unsigned char* ws;
    __device__ __forceinline__ void operator()(const f32x4 (&acc)[2][2][4][2], const pg8::Unit& u, int wr, int wc, int fr, int fq) const {
        const int type = u.pn >> 1, head = (u.pn & 1) * 4 + wc;
        const int rowb = u.pm * 256 + wr * 64 + fr;
        const float* ssq = (const float*)(ws + WS_SSQ); bf16_t* QK = (bf16_t*)(ws + WS_QK);
        const float* cos32 = (const float*)(ws + WS_COS32); const float* sin32 = (const float*)(ws + WS_SIN32);
        float rsv[2][4];
#pragma unroll
        for (int ai = 0; ai < 2; ++ai)
#pragma unroll
            for (int m = 0; m < 4; ++m) rsv[ai][m] = ssq[rowb + ai * 128 + m * 16];
#pragma unroll
        for (int ai = 0; ai < 2; ++ai)
#pragma unroll
            for (int m = 0; m < 4; ++m) { rsv[ai][m] = rsqrtf(rsv[ai][m] * (1.f / DMODEL) + EPS); asm volatile("" : "+v"(rsv[ai][m])); }
        const float* g = (const float*)(ws + WS_PAR) + (type == 0 ? PB_QN : PB_KN); const float qs = type == 0 ? QSCALE_D : 1.f;
        const f32x4 g0 = *(const f32x4*)(g + 4 * fq), g1 = *(const f32x4*)(g + 16 + 4 * fq);
#pragma unroll
        for (int ai = 0; ai < 2; ++ai)
#pragma unroll
            for (int m = 0; m < 4; ++m) {
                const int row = rowb + ai * 128 + m * 16, t = row & (SEQL - 1);
                const float rs = rsv[ai][m];
                const f32x4 c = *(const f32x4*)(cos32 + t * 16 + 4 * fq), s = *(const f32x4*)(sin32 + t * 16 + 4 * fq);
#pragma unroll
                for (int bj = 0; bj < 2; ++bj) {
                    const f32x4 v0 = acc[ai][bj][m][0] * rs, v1 = acc[ai][bj][m][1] * rs;
                    float ss = dot4(v0) + dot4(v1); ss += __shfl_xor(ss, 16); ss += __shfl_xor(ss, 32);
                    const float r = rsqrtf(ss * (1.f / 32.f) + EPS);
                    const f32x4 y0 = v0 * r * g0, y1 = v1 * r * g1;
                    const f32x4 o0 = (y0 * c - y1 * s) * qs, o1 = (y1 * c + y0 * s) * qs;
                    bf16_t* dst = QK + (size_t)row * 2048 + type * 512 + head * 64 + bj * 32 + 8 * fq;
                    const u32x2 p0 = pk4(o0), p1 = pk4(o1); *(u32x4*)dst = (u32x4){p0.x, p0.y, p1.x, p1.y};
                }
            }
    }
};
struct EpiMobaQK {
    static constexpr bool PERM = false, AFTER_DRAIN = false;
    unsigned char* ws;
    __device__ __forceinline__ void operator()(const f32x4 (&acc)[2][2][4][2], const pg8::Unit& u, int wr, int wc, int fr, int fq) const {
        const int type = u.pn >> 1, head = (u.pn & 1) * 4 + wc;
        const int rowb = u.pm * 256 + wr * 64 + fr;
        const float* ssq = (const float*)(ws + WS_SSQ); bf16_t* QK = (bf16_t*)(ws + WS_QK);
        const float* cos64 = (const float*)(ws + WS_COS64); const float* sin64 = (const float*)(ws + WS_SIN64);
        float rsv[2][4];
#pragma unroll
        for (int ai = 0; ai < 2; ++ai)
#pragma unroll
            for (int m = 0; m < 4; ++m) rsv[ai][m] = ssq[rowb + ai * 128 + m * 16];
#pragma unroll
        for (int ai = 0; ai < 2; ++ai)
#pragma unroll
            for (int m = 0; m < 4; ++m) { rsv[ai][m] = rsqrtf(rsv[ai][m] * (1.f / DMODEL) + EPS); asm volatile("" : "+v"(rsv[ai][m])); }
        const float* g = (const float*)(ws + WS_PAR) + (type == 0 ? PB_MQN : PB_MKN); const float qs = type == 0 ? QSCALE_M : 1.f;
        f32x4 gg[2][2], cs[2][2];
#pragma unroll
        for (int bj = 0; bj < 2; ++bj)
#pragma unroll
            for (int n = 0; n < 2; ++n) { gg[bj][n] = *(const f32x4*)(g + 32 * bj + 16 * n + 4 * fq); cs[bj][n] = (f32x4){0.f, 0.f, 0.f, 0.f}; }
#pragma unroll
        for (int ai = 0; ai < 2; ++ai)
#pragma unroll
            for (int m = 0; m < 4; ++m) {
                const int row = rowb + ai * 128 + m * 16, t = row & (SEQL - 1);
                const float rs = rsv[ai][m];
                f32x4 v[2][2]; float ss = 0.f;
#pragma unroll
                for (int bj = 0; bj < 2; ++bj)
#pragma unroll
                    for (int n = 0; n < 2; ++n) { v[bj][n] = acc[ai][bj][m][n] * rs; ss += dot4(v[bj][n]); }
                ss += __shfl_xor(ss, 16); ss += __shfl_xor(ss, 32);
                const float r = rsqrtf(ss * (1.f / 64.f) + EPS);
                bf16_t* dst = QK + (size_t)row * 2048 + 1024 + type * 512 + head * 64 + 16 * fq;
                u32x4 w0, w1;
#pragma unroll
                for (int n = 0; n < 2; ++n) {
                    const f32x4 c = *(const f32x4*)(cos64 + t * 32 + 16 * n + 4 * fq), s = *(const f32x4*)(sin64 + t * 32 + 16 * n + 4 * fq);
                    const f32x4 y0 = v[0][n] * r * gg[0][n], y1 = v[1][n] * r * gg[1][n];
                    const f32x4 o0 = (y0 * c - y1 * s) * qs, o1 = (y1 * c + y0 * s) * qs;
                    const u32x2 p0 = pk4(o0), p1 = pk4(o1);
                    if (n == 0) { w0.x = p0.x; w0.y = p0.y; w1.x = p1.x; w1.y = p1.y; } else { w0.z = p0.x; w0.w = p0.y; w1.z = p1.x; w1.w = p1.y; }
                    cs[0][n] += o0; cs[1][n] += o1;
                }
                *(u32x4*)dst = w0; *(u32x4*)(dst + 8) = w1;
            }
        if (type == 1) {
            float* kbar = (float*)(ws + WS_KBAR);
#pragma unroll
            for (int bj = 0; bj < 2; ++bj)
#pragma unroll
                for (int n = 0; n < 2; ++n)
#pragma unroll
                    for (int j = 0; j < 4; ++j) {
                        float x = cs[bj][n][j];
                        x += __shfl_xor(x, 1); x += __shfl_xor(x, 2); x += __shfl_xor(x, 4); x += __shfl_xor(x, 8);
                        if (fr == 0) unsafeAtomicAdd(kbar + ((size_t)u.pm * 8 + head) * 64 + 16 * fq + 8 * bj + 4 * n + j, x);
                    }
        }
    }
};
struct EpiV {
    static constexpr bool PERM = false, AFTER_DRAIN = true;
    unsigned char* ws;
    __device__ __forceinline__ void fused(f32x4 (&acc)[2][2][4][2], const pg8::Unit& u, int wr, int wc, int fr, int fq, LAS unsigned char* lds, int wid, int lane) const {
        constexpr int TP = 264;
        LAS bf16_t* T = (LAS bf16_t*)lds;
        const float* ssq = (const float*)(ws + WS_SSQ);
        const int rowb = u.pm * 256 + wr * 64 + fr;
        float rsv[2][4];
#pragma unroll
        for (int ai = 0; ai < 2; ++ai)
#pragma unroll
            for (int m = 0; m < 4; ++m) rsv[ai][m] = ssq[rowb + ai * 128 + m * 16];
#pragma unroll
        for (int ai = 0; ai < 2; ++ai)
#pragma unroll
            for (int m = 0; m < 4; ++m) { rsv[ai][m] = rsqrtf(rsv[ai][m] * (1.f / DMODEL) + EPS); asm volatile("" : "+v"(rsv[ai][m])); }
#pragma unroll
        for (int ai = 0; ai < 2; ++ai)
#pragma unroll
            for (int m = 0; m < 4; ++m) {
                const int row = rowb + ai * 128 + m * 16, tl = ai * 128 + wr * 64 + m * 16 + fr;
                const float rs = rsv[ai][m];
#pragma unroll
                for (int bj = 0; bj < 2; ++bj)
#pragma unroll
                    for (int n = 0; n < 2; ++n) {
                        const f32x4 v = acc[ai][bj][m][n] * rs; const int dl = 64 * wc + 32 * bj + 16 * n + 4 * fq;
                        const u32x2 w = pk4(v);
                        T[(dl + 0) * TP + tl] = (bf16_t)(w.x & 0xffffu); T[(dl + 1) * TP + tl] = (bf16_t)(w.x >> 16);
                        T[(dl + 2) * TP + tl] = (bf16_t)(w.y & 0xffffu); T[(dl + 3) * TP + tl] = (bf16_t)(w.y >> 16);
                    }
            }
        asm volatile("s_waitcnt lgkmcnt(0)" ::: "memory"); __builtin_amdgcn_s_barrier(); asm volatile("" ::: "memory");
        const int tid = wid * 64 + lane, which = u.pn >> 1, b = u.pm >> 4, t0 = (u.pm & 15) * 256;
        bf16_t* base = (bf16_t*)(ws + WS_VT) + ((size_t)((which * 4 + b) * 8 + (u.pn & 1) * 4) * 64) * SEQL + t0;
#pragma unroll 4
        for (int p = 0; p < 16; ++p) {
            const int rd = p * 16 + (tid >> 5), ch = tid & 31;
            const u32x4 w = *(LAS const u32x4*)(T + rd * TP + ch * 8);
            *(u32x4*)(base + (size_t)rd * SEQL + ch * 8) = w;
        }
    }
};

struct EpiResid {
    static constexpr bool PERM = true, AFTER_DRAIN = false;
    const bf16_t* xin; float* xout; bf16_t* xb; float* ssq;
    __device__ __forceinline__ void operator()(const f32x4 (&acc)[2][2][4][2], const pg8::Unit& u, int wr, int wc, int fr, int fq) const {
        const int rowb = u.pm * 256 + wr * 64 + fr, colb = u.pn * 256 + wc * 32 + 8 * fq;
#pragma unroll
        for (int ai = 0; ai < 2; ++ai)
#pragma unroll
            for (int m = 0; m < 4; ++m) {
                const int row = rowb + ai * 128 + m * 16; float ss = 0.f;
#pragma unroll
                for (int bj = 0; bj < 2; ++bj) {
                    const size_t off = (size_t)row * DMODEL + colb + bj * 128;
                    const u32x4 xo = *(const u32x4*)(xin + off);
                    f32x4 x0 = acc[ai][bj][m][0], x1 = acc[ai][bj][m][1];
                    x0[0] += bflo(xo.x); x0[1] += bfhi(xo.x); x0[2] += bflo(xo.y); x0[3] += bfhi(xo.y);
                    x1[0] += bflo(xo.z); x1[1] += bfhi(xo.z); x1[2] += bflo(xo.w); x1[3] += bfhi(xo.w);
                    if (xout) { *(f32x4*)(xout + off) = x0; *(f32x4*)(xout + off + 4) = x1; }
                    if (xb) { const u32x2 p0 = pk4(x0), p1 = pk4(x1); *(u32x4*)(xb + off) = (u32x4){p0.x, p0.y, p1.x, p1.y}; }
                    ss += dot4(x0) + dot4(x1);
                }
                if (ssq) { ss += __shfl_xor(ss, 16); ss += __shfl_xor(ss, 32); if (fq == 0) unsafeAtomicAdd(ssq + row, ss); }
            }
    }
};

struct EpiSwiglu {
    static constexpr bool PERM = true, AFTER_DRAIN = false;
    const float* ssq; bf16_t* act;
    __device__ __forceinline__ void operator()(const f32x4 (&acc)[2][2][4][2], const pg8::Unit& u, int wr, int wc, int fr, int fq) const {
        const int rowb = u.pm * 256 + wr * 64 + fr, colb = u.pn * 128 + wc * 32 + 8 * fq;
        float rsv[2][4];
#pragma unroll
        for (int ai = 0; ai < 2; ++ai)
#pragma unroll
            for (int m = 0; m < 4; ++m) rsv[ai][m] = ssq[rowb + ai * 128 + m * 16];
#pragma unroll
        for (int ai = 0; ai < 2; ++ai)
#pragma unroll
            for (int m = 0; m < 4; ++m) { rsv[ai][m] = rsqrtf(rsv[ai][m] * (1.f / DMODEL) + EPS); asm volatile("" : "+v"(rsv[ai][m])); }
#pragma unroll
        for (int ai = 0; ai < 2; ++ai)
#pragma unroll
            for (int m = 0; m < 4; ++m) {
                const int row = rowb + ai * 128 + m * 16;
                const float rs = rsv[ai][m];
                u32x4 w;
#pragma unroll
                for (int n = 0; n < 2; ++n) {
                    const f32x4 g = acc[ai][0][m][n] * rs, uu = acc[ai][1][m][n] * rs; f32x4 a;
#pragma unroll
                    for (int j = 0; j < 4; ++j) a[j] = g[j] * fast_sigmoid(g[j]) * uu[j];
                    const u32x2 p = pk4(a); if (n == 0) { w.x = p.x; w.y = p.y; } else { w.z = p.x; w.w = p.y; }
                }
                *(u32x4*)(act + (size_t)row * DFF + colb) = w;
            }
    }
};

struct EpiOddIn {
    static constexpr bool PERM = true, AFTER_DRAIN = false;
    unsigned char* ws;
    __device__ __forceinline__ void operator()(const f32x4 (&acc)[2][2][4][2], const pg8::Unit& u, int wr, int wc, int fr, int fq) const {
        const int rowb = u.pm * 256 + wr * 64 + fr;
        const float* ssq = (const float*)(ws + WS_SSQ) + 2 * MTOK; const float* bias = (const float*)(ws + WS_PAR) + PB_OBIAS;
        bf16_t* GU = (bf16_t*)(ws + WS_GU); bf16_t* GV = (bf16_t*)(ws + WS_GV); bf16_t* CP = (bf16_t*)(ws + WS_CP); float* gvst = (float*)(ws + WS_GVST);
        float rsv[2][4];
#pragma unroll
        for (int ai = 0; ai < 2; ++ai)
#pragma unroll
            for (int m = 0; m < 4; ++m) rsv[ai][m] = ssq[rowb + ai * 128 + m * 16];
#pragma unroll
        for (int ai = 0; ai < 2; ++ai)
#pragma unroll
            for (int m = 0; m < 4; ++m) { rsv[ai][m] = rsqrtf(rsv[ai][m] * (1.f / DMODEL) + EPS); asm volatile("" : "+v"(rsv[ai][m])); }
        if (u.pn < 4) {
            const int colb = u.pn * 256 + wc * 32 + 8 * fq;
            bf16_t* dstb = u.pn < 2 ? GU : GV; const int cadj = u.pn < 2 ? 0 : 512;
#pragma unroll
            for (int ai = 0; ai < 2; ++ai)
#pragma unroll
                for (int m = 0; m < 4; ++m) {
                    const int row = rowb + ai * 128 + m * 16;
                    const float rs = rsv[ai][m]; float s1 = 0.f, s2 = 0.f;
#pragma unroll
                    for (int bj = 0; bj < 2; ++bj) {
                        u32x4 w;
#pragma unroll
                        for (int n = 0; n < 2; ++n) {
                            const int col = colb + bj * 128 + n * 4;
                            const f32x4 x = acc[ai][bj][m][n] * rs + *(const f32x4*)(bias + col); f32x4 y;
#pragma unroll
                            for (int j = 0; j < 4; ++j) { const float z = 1.5957691216057308f * (x[j] + 0.044715f * x[j] * x[j] * x[j]); y[j] = x[j] * fast_sigmoid(z); }
                            const u32x2 p = pk4(y); if (n == 0) { w.x = p.x; w.y = p.y; } else { w.z = p.x; w.w = p.y; }
                            s1 += sum4(y); s2 += dot4(y);
                        }
                        *(u32x4*)(dstb + (size_t)row * 512 + colb + bj * 128 - cadj) = w;
                    }
                    if (u.pn >= 2) {
                        s1 += __shfl_xor(s1, 16); s1 += __shfl_xor(s1, 32); s2 += __shfl_xor(s2, 16); s2 += __shfl_xor(s2, 32);
                        if (fq == 0) { unsafeAtomicAdd(gvst + 2 * row, s1); unsafeAtomicAdd(gvst + 2 * row + 1, s2); }
                    }
                }
        } else {
            const int offb = (u.pn - 4) * 128 + wc * 32 + 8 * fq;
#pragma unroll
            for (int ai = 0; ai < 2; ++ai)
#pragma unroll
                for (int m = 0; m < 4; ++m) {
                    const int row = rowb + ai * 128 + m * 16;
                    const float rs = rsv[ai][m];
                    u32x4 w;
#pragma unroll
                    for (int n = 0; n < 2; ++n) {
                        const int off = offb + n * 4;
                        const f32x4 a = acc[ai][0][m][n] * rs + *(const f32x4*)(bias + 1024 + off), gt = acc[ai][1][m][n] * rs + *(const f32x4*)(bias + 1536 + off); f32x4 y;
#pragma unroll
                        for (int j = 0; j < 4; ++j) y[j] = a[j] * fast_sigmoid(gt[j]);
                        const u32x2 p = pk4(y); if (n == 0) { w.x = p.x; w.y = p.y; } else { w.z = p.x; w.w = p.y; }
                    }
                    *(u32x4*)(CP + (size_t)row * 512 + offb) = w;
                }
        }
    }
};

__device__ __forceinline__ int map_row(int mode, int n0) {
    if (mode == 1) { const int seg = n0 >> 9, nseg = seg == 2 ? 4 : (seg == 3 ? 2 : (seg == 4 ? 3 : seg)), l = n0 & 511, pl = l >> 8, l2 = l & 255, wc = l2 >> 6, bj = (l2 >> 5) & 1;
                     return nseg * 512 + pl * 256 + bj * 128 + wc * 32; }
    if (mode == 2) { if (n0 < DFF) return (n0 >> 7) * 256 + (n0 & 127); const int n1 = n0 - DFF; return (n1 >> 7) * 256 + 128 + (n1 & 127); }
    if (mode == 3) { if (n0 < 1024) return n0; if (n0 < 1536) { const int n1 = n0 - 1024; return (4 + (n1 >> 7)) * 256 + (n1 & 127); }
                     const int n1 = n0 - 1536; return (4 + (n1 >> 7)) * 256 + 128 + (n1 & 127); }
    return n0;
}
constexpr int TRP = 65;
__device__ __forceinline__ void tr_item(const float* W, int K, int N, bf16_t* WT, int mode, const float* gk, LAS float* scr, int item, int lane) {
    const int nblk = N / 64, kb = item / nblk, nb = item % nblk, k0 = 64 * kb, n0 = 64 * nb;
    f32x4 v[16];
#pragma unroll
    for (int i = 0; i < 16; ++i) { const int kk = 4 * i + (lane >> 4); v[i] = *(const f32x4*)(W + (size_t)(k0 + kk) * N + n0 + (lane & 15) * 4); }
#pragma unroll
    for (int i = 0; i < 16; ++i) { const int kk = 4 * i + (lane >> 4); f32x4 w = v[i]; if (gk) w = w * gk[k0 + kk]; LAS float* d = scr + kk * TRP + (lane & 15) * 4;
        d[0] = w[0]; d[1] = w[1]; d[2] = w[2]; d[3] = w[3]; }
    asm volatile("s_waitcnt lgkmcnt(0)" ::: "memory");
    const int c = lane & 7, nn = lane >> 3;
#pragma unroll
    for (int j = 0; j < 8; ++j) {
        const int n = nn + 8 * j;
        const LAS float* s = scr + (8 * c) * TRP + n;
        u32x4 o; o.x = cvtpk(s[0 * TRP], s[1 * TRP]); o.y = cvtpk(s[2 * TRP], s[3 * TRP]); o.z = cvtpk(s[4 * TRP], s[5 * TRP]); o.w = cvtpk(s[6 * TRP], s[7 * TRP]);
        *(u32x4*)(WT + (size_t)(map_row(mode, n0 + (n & 32)) + (n & 31)) * K + k0 + 8 * c) = o;
    }
    asm volatile("s_waitcnt lgkmcnt(0)" ::: "memory");
}

constexpr int I_EI = 16 * 48, I_EO = 16 * 16, I_FI = 16 * 88, I_FO = 44 * 16, I_OI = 16 * 32, I_OO = 16 * 16;
__device__ __forceinline__ void convert_late(const Args& a, unsigned char* ws, LAS unsigned char* lds, int gw, int nw, int wid) {
    const int lane = mk_tid(wid) & 63;
    LAS float* scr = (LAS float*)(lds + wid * (64 * TRP * 4));
    constexpr int NITEMS = I_FI + I_FO + I_OI + I_OO;
    for (int it = gw; it < NITEMS; it += nw) {
        int r = it;
        if (r < I_FI) { tr_item(a.in[3] + (size_t)1024 * 5632, 1024, 5632, (bf16_t*)(ws + WS_WFI1), 2, a.in[2] + 1024, scr, r, lane); continue; } r -= I_FI;
        if (r < I_FO) { tr_item(a.in[4] + (size_t)2816 * 1024, 2816, 1024, (bf16_t*)(ws + WS_WFO1), 0, nullptr, scr, r, lane); continue; } r -= I_FO;
        if (r < I_OI) { tr_item(a.in[16], 1024, 2048, (bf16_t*)(ws + WS_WOI), 3, a.in[1] + 1024, scr, r, lane); continue; } r -= I_OI;
        tr_item(a.in[18], 1024, 1024, (bf16_t*)(ws + WS_WOO), 0, nullptr, scr, r, lane);
    }
}
__device__ __forceinline__ void prologue(const Args& a, LAS unsigned char* lds, int vcu, int G, int wid) {
    const int tid = mk_tid(wid), lane = tid & 63;
    unsigned char* ws = a.ws;
    LAS float* scr = (LAS float*)(lds + wid * (64 * TRP * 4));
    const int gw = vcu * 8 + wid, NGW = G * 8;
    constexpr int NITEMS = I_EI + I_EO + I_FI + I_FO;
    for (int it = gw; it < NITEMS; it += NGW) {
        int r = it;
        if (r < I_EI) { tr_item(a.in[5], 1024, 3072, (bf16_t*)(ws + WS_WEI), 1, a.in[1], scr, r, lane); continue; } r -= I_EI;
        if (r < I_EO) { tr_item(a.in[6], 1024, 1024, (bf16_t*)(ws + WS_WEO), 0, nullptr, scr, r, lane); continue; } r -= I_EO;
        if (r < I_FI) { tr_item(a.in[3], 1024, 5632, (bf16_t*)(ws + WS_WFI0), 2, a.in[2], scr, r, lane); continue; } r -= I_FI;
        tr_item(a.in[4], 2816, 1024, (bf16_t*)(ws + WS_WFO0), 0, nullptr, scr, r, lane);
    }
    float* ssq = (float*)(ws + WS_SSQ); bf16_t* XB = (bf16_t*)(ws + WS_XB);
    for (int m = gw; m < MTOK; m += NGW) {
        const f32x4* xr = (const f32x4*)(a.in[0] + (size_t)m * DMODEL) + lane; u32x2* o8 = (u32x2*)(XB + (size_t)m * DMODEL) + lane; float s = 0.f;
#pragma unroll
        for (int j = 0; j < 4; ++j) { const f32x4 v = xr[64 * j]; s += dot4(v); o8[64 * j] = pk4(v); }
        s = wave_sum(s); if (lane == 0) ssq[m] = s;
    }
    const int gt = vcu * 512 + tid, NGT = G * 512;
    for (int i = 16384 + gt; i < 131072; i += NGT) ssq[i] = 0.f;
    for (int i = gt; i < SEQL * 48; i += NGT) {
        const int t = i / 48, e = i % 48; const bool small = e < 16; const int fi = small ? e : e - 16;
        const float inv = 1.0f / powf(10000.0f, small ? (float)fi * (1.f / 16.f) : (float)fi * (1.f / 32.f));
        const float ang = (float)t * inv;
        const double ad = (double)ang, n = rint(ad * 0.15915494309189535), rr = ad - n * 6.283185307179586;
        const float rf = (float)rr, cv = __cosf(rf), sv = __sinf(rf);
        if (small) { ((float*)(ws + WS_COS32))[t * 16 + fi] = cv; ((float*)(ws + WS_SIN32))[t * 16 + fi] = sv; }
        else { ((float*)(ws + WS_COS64))[t * 32 + fi] = cv; ((float*)(ws + WS_SIN64))[t * 32 + fi] = sv; }
    }
    for (int i = gt; i < 8 * 128 * 128; i += NGT) { const int t = (i >> 7) & 127, s = i & 127; ((bf16_t*)(ws + WS_WSB))[i] = s <= t ? f2bf(a.in[21][i]) : (bf16_t)0; }
    if (vcu == 0 && wid == 0) {
        float p1 = 0.f, p2 = 0.f;
        if (lane < 32) { p1 = a.in[9][lane] * a.in[10][lane]; p2 = a.in[11][lane] * a.in[12][lane]; }
        p1 = wave_sum(p1); p2 = wave_sum(p2);
        if (lane == 0) ((float*)(ws + WS_PAR))[PB_LAM] = expf(p1) - expf(p2) + 0.2f;
    }
    {
        float* pb = (float*)(ws + WS_PAR);
        for (int i = gt; i < PB_LAM; i += NGT) {
            float v;
            if (i < PB_KN) v = a.in[7][i - PB_QN]; else if (i < PB_MQN) v = a.in[8][i - PB_KN]; else if (i < PB_MKN) v = a.in[14][i - PB_MQN]; else if (i < PB_SUBLN) v = a.in[15][i - PB_MKN];
            else if (i < PB_OBIAS) v = a.in[13][i - PB_SUBLN]; else if (i < PB_GLNG) v = a.in[17][i - PB_OBIAS]; else if (i < PB_GLNB) v = a.in[19][i - PB_GLNG]; else if (i < PB_GBS) v = a.in[20][i - PB_GLNB];
            else if (i < PB_CW) v = a.in[22][i - PB_GBS]; else if (i < PB_CB) v = a.in[23][i - PB_CW]; else if (i < PB_CLNG) v = a.in[24][i - PB_CB]; else if (i < PB_CLNB) v = a.in[25][i - PB_CLNG]; else v = a.in[26][i - PB_CLNB];
            pb[i] = v;
        }
    }
}

constexpr int KPITCH = 144, VPITCH = 272, KBUF = 128 * KPITCH, VBUF = 64 * VPITCH;
template <bool DIFF>
__device__ __forceinline__ void attn_unit(LAS unsigned char* lds, unsigned char* ws, int b, int hd, int qb, int wid) {
    const float* subln_g = (const float*)(ws + WS_PAR) + PB_SUBLN; bf16_t* MIX = (bf16_t*)(ws + WS_MIX);
    constexpr int NM = DIFF ? 2 : 1;
    const int tid = mk_tid(wid), lane = tid & 63, r = lane & 31, h = lane >> 5;
    const bf16_t* QK = (const bf16_t*)(ws + WS_QK); const bf16_t* VT = (const bf16_t*)(ws + WS_VT);
    const int q0 = qb * 256, qw = q0 + 32 * wid, qrow = qw + r;
    const size_t grow = (size_t)b * SEQL + qrow;
    const bf16_t* Qp = QK + grow * 2048 + (DIFF ? 0 : 1024) + hd * 64;
    const bf16_t* Kg = QK + (size_t)b * SEQL * 2048 + (DIFF ? 512 : 1536) + hd * 64;
    const bf16_t* Vg = VT + ((size_t)(((DIFF ? 0 : 1) * 4 + b) * 8 + hd) * 64) * SEQL;
    bf16x8 qf[4];
#pragma unroll
    for (int i = 0; i < 4; ++i) qf[i] = *(const bf16x8*)(Qp + 16 * i + 8 * h);
    unsigned sel = 0u;
    if (!DIFF) {
        float qv[32];
#pragma unroll
        for (int i = 0; i < 4; ++i) { const u32x4 w = *(const u32x4*)(Qp + 32 * h + 8 * i);
            qv[8 * i + 0] = bflo(w.x); qv[8 * i + 1] = bfhi(w.x); qv[8 * i + 2] = bflo(w.y); qv[8 * i + 3] = bfhi(w.y);
            qv[8 * i + 4] = bflo(w.z); qv[8 * i + 5] = bfhi(w.z); qv[8 * i + 6] = bflo(w.w); qv[8 * i + 7] = bfhi(w.w); }
        float g[15];
        const float* kb0 = (const float*)(ws + WS_KBAR) + ((size_t)(b * 16) * 8 + hd) * 64 + 32 * h;
#pragma unroll
        for (int n = 0; n < 15; ++n) {
            float acc = 0.f;
            if (n < qb) {
                const float* kb = kb0 + (size_t)n * 512;
#pragma unroll
                for (int i = 0; i < 8; ++i) { const f32x4 kv = *(const f32x4*)(kb + 4 * i); acc += qv[4 * i] * kv[0] + qv[4 * i + 1] * kv[1] + qv[4 * i + 2] * kv[2] + qv[4 * i + 3] * kv[3]; }
                acc = hswap_sum(acc);
            }
            g[n] = acc;
        }
#pragma unroll
        for (int pass = 0; pass < 3; ++pass) {
            float best = -INFINITY; int bi = -1;
#pragma unroll
            for (int n = 0; n < 15; ++n) { const bool ok = (n < qb) && !((sel >> n) & 1u) && (g[n] > best); best = ok ? g[n] : best; bi = ok ? n : bi; }
            if (bi >= 0) sel |= 1u << bi;
        }
    }
    f32x16 o[NM][2]; float lrun[NM];
#pragma unroll
    for (int mp = 0; mp < NM; ++mp) { lrun[mp] = 0.f;
#pragma unroll
        for (int d = 0; d < 2; ++d)
#pragma unroll
            for (int i = 0; i < 16; ++i) o[mp][d][i] = 0.f; }
    const int nT = (q0 + 256) / 128;
    const int krow = tid >> 2, kch = tid & 3, vrow = tid >> 3, vch = tid & 7;
    const bf16_t* ksrc = Kg + (size_t)krow * 2048 + kch * 16;
    const bf16_t* vsrc = Vg + (size_t)vrow * SEQL + vch * 16;
    LAS unsigned char* kdst = lds + krow * KPITCH + kch * 32;
    LAS unsigned char* vdst = lds + 2 * KBUF + vrow * VPITCH + vch * 32;
    u32x4 kreg0 = *(const u32x4*)ksrc, kreg1 = *(const u32x4*)(ksrc + 8), vreg0 = *(const u32x4*)vsrc, vreg1 = *(const u32x4*)(vsrc + 8);
#define ATT_STAGE(bo) do { LAS unsigned char* kd_ = kdst + (bo) * KBUF; LAS unsigned char* vd_ = vdst + (bo) * VBUF; \
        *(LAS u32x4*)kd_ = kreg0; *(LAS u32x4*)(kd_ + 16) = kreg1; \
        *(LAS u32x4*)vd_ = (u32x4){vreg0.x, vreg0.y, vreg1.x, vreg1.y}; *(LAS u32x4*)(vd_ + 16) = (u32x4){vreg0.z, vreg0.w, vreg1.z, vreg1.w}; } while (0)
    ATT_STAGE(0);
    __syncthreads();
    for (int t = 0; t < nT; ++t) {
        const int buf = t & 1;
        if (t + 1 < nT) { const bf16_t* kp_ = ksrc + (size_t)(t + 1) * 128 * 2048; const bf16_t* vp_ = vsrc + (t + 1) * 128;
            kreg0 = *(const u32x4*)kp_; kreg1 = *(const u32x4*)(kp_ + 8); vreg0 = *(const u32x4*)vp_; vreg1 = *(const u32x4*)(vp_ + 8); }
#pragma nounroll
        for (int sb = 0; sb < 2; ++sb) {
        const int kv0 = t * 128 + sb * 64, tt = 2 * t + sb;
        bool active = kv0 <= qw + 31;
        const bool past = !DIFF && (tt >> 2) < qb;
        const bool use = past ? ((sel >> (tt >> 2)) & 1u) != 0u : true;
        if (past) active = active && (__ballot(use) != 0ull);
        if (active) {
            LAS const unsigned char* Kt = lds + buf * KBUF + sb * (64 * KPITCH); LAS const unsigned char* Vt = lds + 2 * KBUF + buf * VBUF + sb * 128;
            f32x16 s[NM][2];
#pragma unroll
            for (int kvb = 0; kvb < 2; ++kvb) {
                LAS const unsigned char* kp = Kt + (kvb * 32 + r) * KPITCH + h * 16;
                bf16x8 kf[4];
#pragma unroll
                for (int i = 0; i < 4; ++i) kf[i] = *(LAS const bf16x8*)(kp + 32 * i);
                f32x16 z;
#pragma unroll
                for (int i = 0; i < 16; ++i) z[i] = 0.f;
                if (DIFF) { s[0][kvb] = MFMA32(kf[0], qf[0], z); s[0][kvb] = MFMA32(kf[1], qf[1], s[0][kvb]);
                            s[NM - 1][kvb] = MFMA32(kf[2], qf[2], z); s[NM - 1][kvb] = MFMA32(kf[3], qf[3], s[NM - 1][kvb]); }
                else { s[0][kvb] = MFMA32(kf[0], qf[0], z); s[0][kvb] = MFMA32(kf[1], qf[1], s[0][kvb]); s[0][kvb] = MFMA32(kf[2], qf[2], s[0][kvb]); s[0][kvb] = MFMA32(kf[3], qf[3], s[0][kvb]); }
            }
            if (kv0 + 63 > qw) {
#pragma unroll
                for (int kvb = 0; kvb < 2; ++kvb)
#pragma unroll
                    for (int i = 0; i < 16; ++i) { const bool dead = kv0 + 32 * kvb + crow(i, h) > qrow;
#pragma unroll
                        for (int mp = 0; mp < NM; ++mp) s[mp][kvb][i] = dead ? -INFINITY : s[mp][kvb][i]; }
            }
#pragma unroll
            for (int mp = 0; mp < NM; ++mp) {
                float rsum = 0.f;
#pragma unroll
                for (int kvb = 0; kvb < 2; ++kvb)
#pragma unroll
                    for (int i = 0; i < 16; ++i) { const float p = __builtin_amdgcn_exp2f(s[mp][kvb][i]); s[mp][kvb][i] = p; rsum += p; }
                lrun[mp] += use ? rsum : 0.f;
            }
#pragma unroll
            for (int kvb = 0; kvb < 2; ++kvb)
#pragma unroll
                for (int ss = 0; ss < 2; ++ss) {
                    bf16x8 pb[NM];
#pragma unroll
                    for (int mp = 0; mp < NM; ++mp) { u32x4 w; w.x = cvtpk(s[mp][kvb][8 * ss + 0], s[mp][kvb][8 * ss + 1]); w.y = cvtpk(s[mp][kvb][8 * ss + 2], s[mp][kvb][8 * ss + 3]);
                        w.z = cvtpk(s[mp][kvb][8 * ss + 4], s[mp][kvb][8 * ss + 5]); w.w = cvtpk(s[mp][kvb][8 * ss + 6], s[mp][kvb][8 * ss + 7]);
                        if (past) { w.x = use ? w.x : 0u; w.y = use ? w.y : 0u; w.z = use ? w.z : 0u; w.w = use ? w.w : 0u; }
                        pb[mp] = __builtin_bit_cast(bf16x8, w); }
#pragma unroll
                    for (int d = 0; d < 2; ++d) {
                        const bf16x8 va = *(LAS const bf16x8*)(Vt + (32 * d + r) * VPITCH + (kvb * 32 + 16 * ss + 8 * h) * 2);
#pragma unroll
                        for (int mp = 0; mp < NM; ++mp) o[mp][d] = MFMA32(va, pb[mp], o[mp][d]);
                    }
                }
        }
        }
        if (t + 1 < nT) ATT_STAGE(buf ^ 1);
        __syncthreads();
    }
#undef ATT_STAGE
    float inv[NM];
#pragma unroll
    for (int mp = 0; mp < NM; ++mp) inv[mp] = 1.f / hswap_sum(lrun[mp]);
    float rn = 1.f;
    if (DIFF) {
        const float lam = ((const float*)(ws + WS_PAR))[PB_LAM]; float ss = 0.f;
#pragma unroll
        for (int d = 0; d < 2; ++d)
#pragma unroll
            for (int i = 0; i < 16; ++i) { const float v = o[0][d][i] * inv[0] - lam * (o[NM - 1][d][i] * inv[NM - 1]); o[0][d][i] = v; ss += v * v; }
        ss = hswap_sum(ss);
        rn = rsqrtf(ss * (1.f / 64.f) + EPS) * 0.8f;
    }
    bf16_t* orow = MIX + grow * DMODEL + (DIFF ? 0 : 512) + hd * 64;
#pragma unroll
    for (int d = 0; d < 2; ++d) {
        u32x2 pk[4];
#pragma unroll
        for (int g4 = 0; g4 < 4; ++g4) { const int d0 = 32 * d + 8 * g4 + 4 * h; f32x4 v;
            if (DIFF) { const f32x4 gw = *(const f32x4*)(subln_g + d0); v[0] = o[0][d][4 * g4] * rn * gw[0]; v[1] = o[0][d][4 * g4 + 1] * rn * gw[1]; v[2] = o[0][d][4 * g4 + 2] * rn * gw[2]; v[3] = o[0][d][4 * g4 + 3] * rn * gw[3]; }
            else { v[0] = o[0][d][4 * g4] * inv[0]; v[1] = o[0][d][4 * g4 + 1] * inv[0]; v[2] = o[0][d][4 * g4 + 2] * inv[0]; v[3] = o[0][d][4 * g4 + 3] * inv[0]; }
            pk[g4] = pk4(v); }
#pragma unroll
        for (int gp = 0; gp < 2; ++gp) {
            const auto r0 = __builtin_amdgcn_permlane32_swap(pk[2 * gp].x, pk[2 * gp + 1].x, false, false);
            const auto r1 = __builtin_amdgcn_permlane32_swap(pk[2 * gp].y, pk[2 * gp + 1].y, false, false);
            const u32x4 w = {r0[0], r1[0], r0[1], r1[1]};
            *(u32x4*)(orow + 32 * d + 8 * (2 * gp + h)) = w;
        }
    }
}

__device__ __forceinline__ void gmlp_item(LAS unsigned char* lds, unsigned char* ws, int item, int wid) {
    const int tid = mk_tid(wid), lane = tid & 63, r = lane & 31, h = lane >> 5;
    const float* pb = (const float*)(ws + WS_PAR);
    const bf16_t* GU = (const bf16_t*)(ws + WS_GU); const bf16_t* GV = (const bf16_t*)(ws + WS_GV); const float* gvst = (const float*)(ws + WS_GVST);
    const bf16_t* WSB = (const bf16_t*)(ws + WS_WSB); bf16_t* MIX = (bf16_t*)(ws + WS_MIX);
    const int ch = item >> 2, g0 = (item & 3) * 2; const size_t row0 = (size_t)ch * 128;
    constexpr int GP = 136;
    const int mb = wid & 3, grp = wid >> 2, g = g0 + grp;
    const int s = tid >> 2, dc = (tid & 3) * 32; const size_t frow = row0 + s;
    const bf16_t* src = GV + frow * 512 + g0 * 64 + dc;
    const u32x4 w0 = *(const u32x4*)src, w1 = *(const u32x4*)(src + 8), w2 = *(const u32x4*)(src + 16), w3 = *(const u32x4*)(src + 24);
    const float s1 = gvst[2 * frow], s2 = gvst[2 * frow + 1];
    const bf16_t* Wp = WSB + ((size_t)g * 128 + 32 * mb + r) * 128 + 8 * h;
    bf16x8 wv[8];
#pragma unroll
    for (int kk = 0; kk < 8; ++kk) wv[kk] = *(const bf16x8*)(Wp + 16 * kk);
    const int t = 32 * mb + r; const size_t orow = row0 + t;
    const float bs = pb[PB_GBS + g * 128 + t];
    u32x2 guv[2][4];
#pragma unroll
    for (int nb = 0; nb < 2; ++nb)
#pragma unroll
        for (int gp = 0; gp < 2; ++gp) {
            const u32x4 w = *(const u32x4*)(GU + orow * 512 + g * 64 + 32 * nb + 8 * (2 * gp + h));
            const auto rx = __builtin_amdgcn_permlane32_swap(w.x, w.z, false, false); const auto ry = __builtin_amdgcn_permlane32_swap(w.y, w.w, false, false);
            guv[nb][2 * gp] = (u32x2){rx[0], ry[0]}; guv[nb][2 * gp + 1] = (u32x2){rx[1], ry[1]};
        }
    {
        const float mean = s1 * (1.f / 512.f), var = fmaxf(s2 * (1.f / 512.f) - mean * mean, 0.f), rstd = rsqrtf(var + EPS);
        const float* lg = pb + PB_GLNG + g0 * 64 + dc; const float* lb = pb + PB_GLNB + g0 * 64 + dc;
        LAS bf16_t* dst = (LAS bf16_t*)lds + dc * GP + s;
        const unsigned ww[16] = {w0.x, w0.y, w0.z, w0.w, w1.x, w1.y, w1.z, w1.w, w2.x, w2.y, w2.z, w2.w, w3.x, w3.y, w3.z, w3.w};
#pragma unroll
        for (int i = 0; i < 16; ++i) {
            const float y0 = (bflo(ww[i]) - mean) * rstd * lg[2 * i] + lb[2 * i], y1 = (bfhi(ww[i]) - mean) * rstd * lg[2 * i + 1] + lb[2 * i + 1];
            dst[(2 * i) * GP] = f2bf(y0); dst[(2 * i + 1) * GP] = f2bf(y1);
        }
    }
    __syncthreads();
    f32x16 acc[2];
#pragma unroll
    for (int i = 0; i < 16; ++i) { acc[0][i] = 0.f; acc[1][i] = 0.f; }
    LAS const unsigned char* Ap = lds + ((grp * 64 + r) * GP + 8 * h) * 2;
#pragma unroll
    for (int kk = 0; kk < 8; ++kk)
        if (kk < 2 * (mb + 1)) { const bf16x8 a0 = *(LAS const bf16x8*)(Ap + 32 * kk), a1 = *(LAS const bf16x8*)(Ap + 32 * GP * 2 + 32 * kk);
            acc[0] = MFMA32(a0, wv[kk], acc[0]); acc[1] = MFMA32(a1, wv[kk], acc[1]); }
#pragma unroll
    for (int nb = 0; nb < 2; ++nb) {
        u32x2 pk[4];
#pragma unroll
        for (int g4 = 0; g4 < 4; ++g4) { const u32x2 u = guv[nb][g4]; f32x4 v;
            v[0] = bflo(u.x) * (acc[nb][4 * g4] + bs); v[1] = bfhi(u.x) * (acc[nb][4 * g4 + 1] + bs); v[2] = bflo(u.y) * (acc[nb][4 * g4 + 2] + bs); v[3] = bfhi(u.y) * (acc[nb][4 * g4 + 3] + bs);
            pk[g4] = pk4(v); }
#pragma unroll
        for (int gp = 0; gp < 2; ++gp) {
            const auto r0 = __builtin_amdgcn_permlane32_swap(pk[2 * gp].x, pk[2 * gp + 1].x, false, false);
            const auto r1 = __builtin_amdgcn_permlane32_swap(pk[2 * gp].y, pk[2 * gp + 1].y, false, false);
            *(u32x4*)(MIX + orow * DMODEL + g * 64 + 32 * nb + 8 * (2 * gp + h)) = (u32x4){r0[0], r1[0], r0[1], r1[1]};
        }
    }
    __syncthreads();
}
__device__ __forceinline__ void conv_item(LAS unsigned char* lds, unsigned char* ws, int item, int wid) {
    const float* pb = (const float*)(ws + WS_PAR);
    const int tid = mk_tid(wid), lane = tid & 63;
    const bf16_t* CP = (const bf16_t*)(ws + WS_CP); bf16_t* MIX = (bf16_t*)(ws + WS_MIX);
    constexpr int CT = 64, HT = 32;
    const size_t row0 = (size_t)item * CT; const int half = tid >> 8, c2 = (tid & 255) * 2;
    const size_t hrow0 = row0 + half * HT; const int pos0 = (int)(hrow0 & (SEQL - 1));
    f32x2_t in[HT + 30];
#pragma unroll
    for (int i = 0; i < HT + 30; ++i) { const int p = pos0 + i - 30; unsigned w = 0u; if (p >= 0) w = *(const unsigned*)(CP + (hrow0 + i - 30) * 512 + c2); in[i] = (f32x2_t){bflo(w), bfhi(w)}; }
    f32x2_t w[31];
#pragma unroll
    for (int k = 0; k < 31; ++k) w[k] = *(const f32x2_t*)(pb + PB_CW + k * 512 + c2);
    const f32x2_t bb = *(const f32x2_t*)(pb + PB_CB + c2);
    LAS float* outl = (LAS float*)lds;
#pragma unroll
    for (int t = 0; t < HT; ++t) { f32x2_t acc = bb;
#pragma unroll
        for (int k = 0; k < 31; ++k) acc = __builtin_elementwise_fma(w[k], in[t + k], acc);
        *(LAS f32x2_t*)(outl + (half * HT + t) * 512 + c2) = acc; }
    __syncthreads();
    const f32x4 g0 = *(const f32x4*)(pb + PB_CLNG + lane * 8), g1 = *(const f32x4*)(pb + PB_CLNG + lane * 8 + 4), b0 = *(const f32x4*)(pb + PB_CLNB + lane * 8), b1 = *(const f32x4*)(pb + PB_CLNB + lane * 8 + 4);
#pragma unroll
    for (int tt = 0; tt < CT / 8; ++tt) {
        const int t = (CT / 8) * wid + tt;
        const f32x4 v0 = *(LAS const f32x4*)(outl + t * 512 + lane * 8), v1 = *(LAS const f32x4*)(outl + t * 512 + lane * 8 + 4);
        const float s1 = wave_sum(sum4(v0) + sum4(v1)), mean = s1 * (1.f / 512.f);
        const f32x4 d0 = v0 - mean, d1 = v1 - mean;
        const float s2 = wave_sum(dot4(d0) + dot4(d1)), rstd = rsqrtf(s2 * (1.f / 512.f) + EPS);
        f32x4 y0 = d0 * rstd * g0 + b0, y1 = d1 * rstd * g1 + b1;
#pragma unroll
        for (int j = 0; j < 4; ++j) { y0[j] = y0[j] * fast_sigmoid(y0[j]); y1[j] = y1[j] * fast_sigmoid(y1[j]); }
        u32x4 o; o.x = cvtpk(y0[0], y0[1]); o.y = cvtpk(y0[2], y0[3]); o.z = cvtpk(y1[0], y1[1]); o.w = cvtpk(y1[2], y1[3]);
        *(u32x4*)(MIX + (row0 + t) * DMODEL + 512 + lane * 8) = o;
    }
    __syncthreads();
}

#define XB_TMO      128
#define XB_XCNT(j)  (256  + 64 * (j))
#define XB_XSUB(j)  (1280 + 64 * (j))
#define XB_XGEN(j)  (2304 + 64 * (j))
#define XB_TOP      3328
#define XB_TOPGEN   3392
#define XCD_BAR_WORDS 3456
#define XB_SPIN_CAP (1u << 18)

__device__ __forceinline__ unsigned xb_ld(unsigned* p)              { return __hip_atomic_load(p, __ATOMIC_RELAXED, __HIP_MEMORY_SCOPE_AGENT); }
__device__ __forceinline__ unsigned xb_add(unsigned* p, unsigned v) { return __hip_atomic_fetch_add(p, v, __ATOMIC_RELAXED, __HIP_MEMORY_SCOPE_AGENT); }
__device__ __forceinline__ unsigned xb_xcc_id() { return (unsigned)__builtin_amdgcn_s_getreg((3 << 11) | 20) & 0xFu; }
#define XB_SPIN(cond, bar) do { unsigned _sp = 0; while (cond) { __builtin_amdgcn_s_sleep(1); \
    if ((++_sp & 255u) == 0u) { if (xb_ld(&(bar)[XB_TMO])) break; if (_sp > XB_SPIN_CAP) { atomicAdd(&(bar)[XB_TMO], 1u); break; } } } } while (0)

struct XcdBarrier {
    unsigned* bar; unsigned x;
    volatile LAS unsigned* st;
};

__device__ __forceinline__ XcdBarrier xcd_barrier_post(unsigned* bar, volatile LAS unsigned* st) {
    XcdBarrier b; b.bar = bar; b.x = xb_xcc_id(); b.st = st;
    if (threadIdx.x == 0) (void)xb_add(&bar[XB_XCNT(b.x)], 1u);
    return b;
}
__device__ __forceinline__ void xcd_barrier_complete(unsigned* bar, unsigned x, unsigned& nloc, unsigned& nx) {
    const unsigned G = gridDim.x * gridDim.y * gridDim.z;
    unsigned sum, cnt, mine, sp = 0u;
    for (;;) {
        sum = 0u; cnt = 0u; mine = 0u;
#pragma unroll
        for (unsigned j = 0; j < 16; ++j) { const unsigned c = xb_ld(&bar[XB_XCNT(j)]); sum += c; cnt += (c > 0u) ? 1u : 0u; mine = (j == x) ? c : mine; }
        if (sum == G) break;
        __builtin_amdgcn_s_sleep(1);
        if ((++sp & 255u) == 0u) { if (xb_ld(&bar[XB_TMO])) break; if (sp > XB_SPIN_CAP) { atomicAdd(&bar[XB_TMO], 1u); break; } }
    }
    nloc = mine > 0u ? mine : 1u; nx = cnt > 0u ? cnt : 1u;
}

__device__ __forceinline__ void xcd_barrier(const XcdBarrier& b) {
    asm volatile("s_waitcnt vmcnt(0)" ::: "memory");
    __syncthreads();
    if (threadIdx.x == 0) {
        unsigned* bar = b.bar;
        __builtin_amdgcn_s_waitcnt(0);
        unsigned nloc = b.st[0], nx = b.st[1];
        if (nloc == 0u) { xcd_barrier_complete(bar, b.x, nloc, nx); b.st[0] = nloc; b.st[1] = nx; }
        const unsigned old = xb_add(&bar[XB_XSUB(b.x)], 1u);
        const unsigned gen = old / nloc;
        if (old + 1u == (gen + 1u) * nloc) {
            __builtin_amdgcn_fence(__ATOMIC_RELEASE, "agent");
            asm volatile("s_waitcnt vmcnt(0)" ::: "memory");
            const unsigned og = xb_add(&bar[XB_TOP], 1u);
            const unsigned tg = og / nx;
            if (og + 1u == (tg + 1u) * nx) xb_add(&bar[XB_TOPGEN], 1u);
            else XB_SPIN(xb_ld(&bar[XB_TOPGEN]) == tg, bar);
            __builtin_amdgcn_fence(__ATOMIC_ACQUIRE, "agent");
            xb_add(&bar[XB_XGEN(b.x)], 1u);
            asm volatile("s_waitcnt vmcnt(0)" ::: "memory");
        } else {
            XB_SPIN(xb_ld(&bar[XB_XGEN(b.x)]) == gen, bar);
            __builtin_amdgcn_fence(__ATOMIC_ACQUIRE, "agent");
            asm volatile("s_waitcnt vmcnt(0)" ::: "memory");
        }
    }
    __syncthreads();
}

#define WSP(var) __attribute__((address_space(1))) unsigned char* var##_g = (__attribute__((address_space(1))) unsigned char*)a.ws; asm volatile("" : "+s"(var##_g)); unsigned char* var = (unsigned char*)var##_g
template <int LAYER> __device__ __forceinline__ void tail_phases(const Args& a, LAS unsigned char* lds, const XcdBarrier& bar, int G, int bx, int wid) {
    {
        WSP(ws);
        pg8::Gemm g{(const bf16_t*)(ws + WS_MIX), (const bf16_t*)(ws + (LAYER == 0 ? WS_WEO : WS_WOO)), MTOK, 1024, 1024}; pg8::StaticOrder S; S.init(MTOK, 1024, G, bx);
        EpiResid E{(const bf16_t*)(ws + WS_XB), nullptr, (bf16_t*)(ws + WS_XB), (float*)(ws + WS_SSQ) + (LAYER == 0 ? 1 : 3) * MTOK};
#ifndef NO_GR
        pg8::gemm_phase<EpiResid, pg8::StaticOrder, true, true>(lds, g, S, E, wid);
#endif
    }
    xcd_barrier(bar);
    {
        WSP(ws);
        pg8::Gemm g{(const bf16_t*)(ws + WS_XB), (const bf16_t*)(ws + (LAYER == 0 ? WS_WFI0 : WS_WFI1)), MTOK, 2 * DFF, 1024}; pg8::StaticOrder S; S.init(MTOK, 2 * DFF, G, bx);
        EpiSwiglu E{(const float*)(ws + WS_SSQ) + (LAYER == 0 ? 1 : 3) * MTOK, (bf16_t*)(ws + WS_ACT)};
#ifndef NO_GS
        pg8::gemm_phase<EpiSwiglu, pg8::StaticOrder, true, true>(lds, g, S, E, wid);
#endif
        if (LAYER == 0) { const int n6 = (MTOK / 256) * (2 * DFF / 256) - 5 * G;
            if (G == 256 && bx >= n6) convert_late(a, ws, lds, (bx - n6) * 8 + wid, (G - n6) * 8, wid);
            else if (G != 256 && bx == 0) convert_late(a, ws, lds, wid, 8, wid); }
    }
    xcd_barrier(bar);
    {
        WSP(ws);
        pg8::Gemm g{(const bf16_t*)(ws + WS_ACT), (const bf16_t*)(ws + (LAYER == 0 ? WS_WFO0 : WS_WFO1)), MTOK, 1024, DFF}; pg8::StaticOrder S; S.init(MTOK, 1024, G, bx);
        EpiResid E{(const bf16_t*)(ws + WS_XB), LAYER == 0 ? nullptr : a.out, LAYER == 0 ? (bf16_t*)(ws + WS_XB) : nullptr, LAYER == 0 ? (float*)(ws + WS_SSQ) + 2 * MTOK : nullptr};
#ifndef NO_GR
        pg8::gemm_phase<EpiResid, pg8::StaticOrder, true, true>(lds, g, S, E, wid);
#endif
    }
}

__global__ void __launch_bounds__(512, 2) mega_fwd(Args a) {
    extern __shared__ __attribute__((aligned(16))) unsigned char smem[];
    LAS unsigned char* lds = (LAS unsigned char*)smem;
    const int G = gridDim.x, bx = blockIdx.x, wid = __builtin_amdgcn_readfirstlane(threadIdx.x >> 6);
#define VCU ((G % 8 == 0) ? (bx % 8) * (G / 8) + bx / 8 : bx)
    if (threadIdx.x < 2) ((volatile LAS unsigned*)(lds + LDS_BYTES - 64))[threadIdx.x] = 0u;
    __syncthreads();
    const XcdBarrier bar = xcd_barrier_post((unsigned*)(a.ws + WS_BAR), (volatile LAS unsigned*)(lds + LDS_BYTES - 64));
#ifndef NO_PRO
    prologue(a, lds, VCU, G, wid);
#endif
    xcd_barrier(bar);
    {
        WSP(ws);
        pg8::Gemm g{(const bf16_t*)(ws + WS_XB), (const bf16_t*)(ws + WS_WEI), MTOK, 1024, 1024}; pg8::StaticOrder S; S.init(MTOK, 1024, G, bx); EpiDiffQK E{ws};
#ifndef NO_GEI
        pg8::gemm_phase<EpiDiffQK, pg8::StaticOrder, true, true>(lds, g, S, E, wid);
#endif
    }
    {
        WSP(ws);
        pg8::Gemm g{(const bf16_t*)(ws + WS_XB), (const bf16_t*)(ws + WS_WEI) + (size_t)1024 * 1024, MTOK, 1024, 1024}; pg8::StaticOrder S; S.init(MTOK, 1024, G, bx); EpiMobaQK E{ws};
#ifndef NO_GEI
        pg8::gemm_phase<EpiMobaQK, pg8::StaticOrder, true, true>(lds, g, S, E, wid);
#endif
    }
    {
        WSP(ws);
        pg8::Gemm g{(const bf16_t*)(ws + WS_XB), (const bf16_t*)(ws + WS_WEI) + (size_t)2048 * 1024, MTOK, 1024, 1024}; pg8::StaticOrder S; S.init(MTOK, 1024, G, bx); EpiV E{ws};
#ifndef NO_GEI
        pg8::gemm_phase<EpiV, pg8::StaticOrder, false, true>(lds, g, S, E, wid);
#endif
    }
    xcd_barrier(bar);
    {
        WSP(ws);
        for (int u = VCU; u < 256; u += G) {
            const int bh = u >> 3, s = u & 7, b = bh >> 3, hd = bh & 7;
#ifndef NO_AD
#pragma nounroll
            for (int k = 0; k < 2; ++k) attn_unit<true>(lds, ws, b, hd, k == 0 ? 15 - s : s, wid);
#endif
#ifndef NO_AM
#pragma nounroll
            for (int k = 0; k < 2; ++k) attn_unit<false>(lds, ws, b, hd, k == 0 ? 15 - s : s, wid);
#endif
        }
    }
    xcd_barrier(bar);
    tail_phases<0>(a, lds, bar, G, bx, wid);
    xcd_barrier(bar);
    {
        WSP(ws);
        pg8::Gemm g{(const bf16_t*)(ws + WS_XB), (const bf16_t*)(ws + WS_WOI), MTOK, 2048, 1024}; pg8::StaticOrder S; S.init(MTOK, 2048, G, bx); EpiOddIn E{ws};
#ifndef NO_GOI
        pg8::gemm_phase<EpiOddIn, pg8::StaticOrder, true, true>(lds, g, S, E, wid);
#endif
    }
    xcd_barrier(bar);
    {
        WSP(ws);
        for (int it = bx; it < 256 + 512; it += G) {
#ifndef NO_GM
            if (it >= 256) gmlp_item(lds, ws, it - 256, wid);
#endif
#ifndef NO_CV
            if (it < 256) conv_item(lds, ws, it, wid);
#endif
        }
    }
    xcd_barrier(bar);
    tail_phases<1>(a, lds, bar, G, bx, wid);
}

extern "C" void kernel_launch(void* const* d_in, const int* in_sizes, int n_in, void* d_out, int out_size, void* d_ws, size_t ws_size, hipStream_t stream) {
    static int grid = 0;
    if (grid == 0) {
        if (n_in != 27 || out_size != MTOK * DMODEL || ws_size < WS_END) { fprintf(stderr, "kernel_launch: unexpected shapes (n_in %d out %d ws %zu)\n", n_in, out_size, ws_size); grid = -1; return; }
        int dev = 0, cus = 0, per_cu = 0;
        hipGetDevice(&dev); hipDeviceGetAttribute(&cus, hipDeviceAttributeMultiprocessorCount, dev);
        hipFuncSetAttribute((const void*)mega_fwd, hipFuncAttributeMaxDynamicSharedMemorySize, LDS_BYTES);
        hipOccupancyMaxActiveBlocksPerMultiprocessor(&per_cu, (const void*)mega_fwd, 512, LDS_BYTES);
        if (per_cu < 1) { fprintf(stderr, "kernel_launch: occupancy query says %d blocks/CU\n", per_cu); per_cu = 1; }
        (void)hipGetLastError();
        grid = cus;
    }
    if (grid < 0) return;
    if (hipMemsetAsync((char*)d_ws + WS_BAR, 0, 3456 * 4, stream) != hipSuccess) { fprintf(stderr, "kernel_launch: memset of the barrier words failed\n"); return; }
    Args a{};
    for (int i = 0; i < 27; ++i) a.in[i] = (const float*)d_in[i];
    a.out = (float*)d_out; a.ws = (unsigned char*)d_ws;
    void* args[] = {&a};
    hipError_t e = hipLaunchCooperativeKernel((const void*)mega_fwd, dim3(grid), dim3(512), args, LDS_BYTES, stream);
    if (e != hipSuccess) fprintf(stderr, "cooperative launch failed: %s (grid %d)\n", hipGetErrorString(e), grid);
}
```
